# Optimizing an MI355X kernel written in HIP

```python
import math
import jax, jax.numpy as jnp
from jax import lax
import numpy as np

D_MODEL = 1024
BATCH = 16
SEQ = 4096
DEPTH = 2

F32 = jnp.float32
EPS = 1e-6
N_MEM = 256
N_BRANCH = 4
MAX_POS_OFFSET = 1024

W_A = 512
W_S = 512
S5_GROUP = 16
S5_GROUPS = W_S // S5_GROUP
S5_STATE = 64
MLA_HEADS = 8
Q_LORA = 256
KV_LORA = 256
QK_NOPE = 64
QK_ROPE = 32
V_DIM = 64
ROPE_BASE = 10000.0
Q_BLOCK = 128
W_H = 512
HY_ORDER = 2
HY_EMB = 33
HY_BANDS = (HY_EMB - 1) // 2
HY_FO = 64
HY_FAST_DECAY = 0.3
HY_SLOW_DECAY = 1.5
HY_TARGET = 1e-2
N_IN_A = 3 * W_A
N_IN_S = W_S
N_IN_M = Q_LORA + KV_LORA + QK_ROPE
N_IN_H = 3 * W_H
N_IN_G = N_BRANCH * D_MODEL
N_IN = N_IN_A + N_IN_S + N_IN_M + N_IN_H + N_IN_G
IN_SPLITS = [N_IN_A, N_IN_A + N_IN_S, N_IN_A + N_IN_S + N_IN_M, N_IN_A + N_IN_S + N_IN_M + N_IN_H]
XA_HEADS = 4
XA_DH = 128
N_GROUPS = 4
EXP_PER_GROUP = 8
N_EXPERTS = N_GROUPS * EXP_PER_GROUP
TOP_K = 2
D_FF_E = 256

kernel_name = "hybrid_parallel_gated_encoder"


def rmsnorm(x, g):
    x32 = x.astype(F32)
    y = x32 * lax.rsqrt(jnp.mean(x32 * x32, axis=-1, keepdims=True) + EPS)
    return (y * g.astype(F32)).astype(x.dtype)


def short_conv(u, w):
    up = jnp.pad(u, ((0, 0), (1, 1), (0, 0)))
    return w[0] * up[:, :-2] + w[1] * up[:, 1:-1] + w[2] * up[:, 2:]


def mixer_short_conv(p_a, conv_w, w_out):
    b_gate, c_gate, xin = jnp.split(p_a, 3, axis=-1)
    return (b_gate * short_conv(c_gate * xin, conv_w)) @ w_out


def _linear_recurrence(e1, e2):
    a1, b1 = e1
    a2, b2 = e2
    return a1 * a2, a2 * b1 + b2


def mixer_s5(u, lam_re, lam_im, log_step, b_re, b_im, c_re, c_im, d_skip, w_glu):
    bsz, seqlen, _ = u.shape
    u32 = u.astype(F32)
    ug = u32.reshape(bsz, seqlen, S5_GROUPS, S5_GROUP)
    y = d_skip.astype(F32) * u32
    for direction in range(2):
        lam = lax.complex(lam_re[direction].astype(F32), lam_im[direction].astype(F32))
        delta = jnp.exp(log_step[direction].astype(F32))[:, None]
        lam_bar = jnp.exp(lam * delta)
        b_mat = lax.complex(b_re[direction].astype(F32), b_im[direction].astype(F32))
        b_bar = ((lam_bar - 1.0) / lam)[..., None] * b_mat
        bu = jnp.einsum('blgh,gph->blgp', ug, b_bar)
        a = jnp.broadcast_to(lam_bar, (1, seqlen) + lam_bar.shape)
        _, states = lax.associative_scan(_linear_recurrence, (a, bu), reverse=(direction == 1), axis=1)
        c_mat = lax.complex(c_re[direction].astype(F32), c_im[direction].astype(F32))
        y = y + jnp.real(jnp.einsum('blgp,ghp->blgh', states, c_mat)).reshape(bsz, seqlen, W_S)
    a_half, g_half = jnp.split(jax.nn.gelu(y) @ w_glu.astype(F32), 2, axis=-1)
    return (a_half * jax.nn.sigmoid(g_half)).astype(u.dtype)


def rope(x, cos, sin):
    x1, x2 = jnp.split(x, 2, axis=-1)
    return jnp.concatenate([x1 * cos - x2 * sin, x1 * sin + x2 * cos], axis=-1)


def mixer_mla(p_m, cos, sin, q_norm, w_q_b, kv_norm, w_kv_b, w_o):
    bsz, seqlen, _ = p_m.shape
    c_q, c_kv, k_rope = jnp.split(p_m, [Q_LORA, Q_LORA + KV_LORA], axis=-1)
    q = (rmsnorm(c_q, q_norm) @ w_q_b).reshape(bsz, seqlen, MLA_HEADS, QK_NOPE + QK_ROPE)
    q_nope, q_rope = jnp.split(q, [QK_NOPE], axis=-1)
    q_rope = rope(q_rope, cos[:, :, None], sin[:, :, None])
    k_rope = rope(k_rope, cos, sin)
    kv = (rmsnorm(c_kv, kv_norm) @ w_kv_b).reshape(bsz, seqlen, MLA_HEADS, QK_NOPE + V_DIM)
    k_nope, v = jnp.split(kv, [QK_NOPE], axis=-1)
    scale = (QK_NOPE + QK_ROPE) ** -0.5
    n_blocks = seqlen // Q_BLOCK

    def to_blocks(t):
        return jnp.moveaxis(t.reshape((bsz, n_blocks, Q_BLOCK) + t.shape[2:]), 1, 0)

    def attend(blk):
        qn, qr = blk
        s = jnp.einsum('bqhd,bkhd->bhqk', qn, k_nope) + jnp.einsum('bqhr,bkr->bhqk', qr, k_rope)
        p = jax.nn.softmax(s.astype(F32) * scale, axis=-1).astype(v.dtype)
        return jnp.einsum('bhqk,bkhd->bqhd', p, v)

    o = lax.map(attend, (to_blocks(q_nope), to_blocks(q_rope)))
    o = jnp.moveaxis(o, 0, 1).reshape(bsz, seqlen, MLA_HEADS * V_DIM)
    return o @ w_o


def hyena_filters(seqlen, w1, b1, w2, b2, w3, freq):
    t = jnp.arange(seqlen, dtype=F32)
    t_norm = t / max(seqlen - 1, 1)
    bands = jnp.linspace(1e-4, HY_BANDS - 1, HY_BANDS, dtype=F32)
    ang = (2.0 * math.pi / seqlen) * t[:, None] * bands[None]
    z = jnp.concatenate([t_norm[:, None], jnp.cos(ang), -jnp.sin(ang)], axis=-1)
    fr = freq.astype(F32)
    h = jnp.sin(fr * (z @ w1.astype(F32) + b1.astype(F32)))
    h = jnp.sin(fr * (h @ w2.astype(F32) + b2.astype(F32)))
    filt = (h @ w3.astype(F32)).reshape(seqlen, HY_ORDER, 2, W_H)
    max_decay = math.log(HY_TARGET) / HY_FAST_DECAY
    min_decay = math.log(HY_TARGET) / HY_SLOW_DECAY
    deltas = jnp.abs(jnp.linspace(min_decay, max_decay, W_H, dtype=F32))
    filt = filt * jnp.exp(-t_norm[:, None, None, None] * deltas)
    fwd, bwd = filt[:, :, 0], filt[:, :, 1]
    k = jnp.concatenate([fwd, jnp.zeros_like(fwd[:1]), bwd[:0:-1]], axis=0)
    k = k * lax.rsqrt(jnp.sum(k * k, axis=0, keepdims=True) + EPS)
    return jnp.fft.rfft(k, axis=0)


def fft_conv(u, k_f, bias):
    seqlen = u.shape[1]
    u32 = u.astype(F32)
    u_f = jnp.fft.rfft(u32, n=2 * seqlen, axis=1)
    y = jnp.fft.irfft(u_f * k_f[None], n=2 * seqlen, axis=1)[:, :seqlen]
    return (y + u32 * bias.astype(F32)).astype(u.dtype)


def mixer_hyena(p_h, conv_w, f_w1, f_b1, f_w2, f_b2, f_w3, f_freq, bias, w_out):
    v, x1, x2 = jnp.split(short_conv(p_h, conv_w), 3, axis=-1)
    k_f = hyena_filters(p_h.shape[1], f_w1, f_b1, f_w2, f_b2, f_w3, f_freq)
    z = x1 * fft_conv(v, k_f[:, 0], bias[0])
    z = x2 * fft_conv(z, k_f[:, 1], bias[1])
    return z @ w_out


def cross_attention(h, mem_n, w_q, w_kv, w_o):
    bsz, seqlen, _ = h.shape
    q = (h @ w_q).reshape(bsz, seqlen, XA_HEADS, XA_DH)
    kv = (mem_n @ w_kv).reshape(bsz, mem_n.shape[1], XA_HEADS, 2 * XA_DH)
    k, v = jnp.split(kv, 2, axis=-1)
    s = jnp.einsum('bqhd,bkhd->bhqk', q, k).astype(F32) * (XA_DH ** -0.5)
    p = jax.nn.softmax(s, axis=-1).astype(v.dtype)
    o = jnp.einsum('bhqk,bkhd->bqhd', p, v).reshape(bsz, seqlen, XA_HEADS * XA_DH)
    return o @ w_o


def hier_moe(h, w_group, b_group, w_expert, b_expert, w_gate, w_up, w_down):
    bsz, seqlen, d = h.shape
    t = h.reshape(-1, d)
    g_logits = (t @ w_group).astype(F32) + b_group.astype(F32)
    g_prob = jax.nn.softmax(g_logits, axis=-1)
    g_idx = jnp.argmax(g_logits, axis=-1)
    g_w = jnp.take_along_axis(g_prob, g_idx[:, None], axis=-1)
    e_logits = ((t @ w_expert).astype(F32) + b_expert.astype(F32)).reshape(-1, N_GROUPS, EXP_PER_GROUP)
    e_logits = jnp.take_along_axis(e_logits, g_idx[:, None, None], axis=1)[:, 0]
    top_v, top_i = lax.top_k(e_logits, TOP_K)
    e_w = jax.nn.softmax(top_v, axis=-1) * g_w
    expert_id = g_idx[:, None] * EXP_PER_GROUP + top_i
    combine = jnp.sum(jax.nn.one_hot(expert_id, N_EXPERTS, dtype=F32) * e_w[..., None], axis=1).astype(h.dtype)
    out = jnp.zeros_like(t)
    for g in range(N_GROUPS):
        sl = slice(g * EXP_PER_GROUP, (g + 1) * EXP_PER_GROUP)
        hid = jax.nn.silu(jnp.einsum('td,edf->tef', t, w_gate[sl])) * jnp.einsum('td,edf->tef', t, w_up[sl])
        out = out + jnp.einsum('tef,efd->td', hid * combine[:, sl, None], w_down[sl])
    return out.reshape(bsz, seqlen, d)


def setup_inputs(seed: int = 0) -> dict:
    key = jax.random.key(seed)
    keys = jax.random.split(key, 80)
    counter = [0]

    def nxt():
        k = keys[counter[0]]
        counter[0] += 1
        return k

    def nrm(shape, scale):
        return jax.random.normal(nxt(), shape, F32) * scale

    def gain(shape):
        return 1.0 + nrm(shape, 0.02)

    L = DEPTH
    G, P = S5_GROUPS, S5_STATE
    inp = {}
    inp['x'] = nrm((BATCH, SEQ, D_MODEL), 1.0)
    inp['mem'] = nrm((BATCH, N_MEM, D_MODEL), 1.0)
    inp['positions'] = (jax.random.randint(nxt(), (BATCH, 1), 0, MAX_POS_OFFSET, dtype=jnp.int32)
                        + jnp.arange(SEQ, dtype=jnp.int32)[None])
    inp['mix_norm'] = gain((L, D_MODEL))
    inp['w_in'] = nrm((L, D_MODEL, N_IN), D_MODEL ** -0.5)
    inp['gate_bias'] = nrm((L, N_BRANCH, D_MODEL), 0.1)
    inp['conv_a'] = nrm((L, 3, W_A), 3 ** -0.5)
    inp['w_out_a'] = nrm((L, W_A, D_MODEL), W_A ** -0.5)
    inp['s5_lambda_re'] = -0.5 + nrm((L, 2, G, P), 0.01)
    inp['s5_lambda_im'] = math.pi * jnp.arange(P, dtype=F32) + nrm((L, 2, G, P), 0.01)
    inp['s5_log_step'] = jax.random.uniform(nxt(), (L, 2, G), F32, math.log(1e-3), math.log(1e-1))
    inp['s5_b_re'] = nrm((L, 2, G, P, S5_GROUP), (2 * S5_GROUP) ** -0.5)
    inp['s5_b_im'] = nrm((L, 2, G, P, S5_GROUP), (2 * S5_GROUP) ** -0.5)
    inp['s5_c_re'] = nrm((L, 2, G, S5_GROUP, P), (2 * P) ** -0.5)
    inp['s5_c_im'] = nrm((L, 2, G, S5_GROUP, P), (2 * P) ** -0.5)
    inp['s5_d'] = nrm((L, W_S), 1.0)
    inp['s5_w_glu'] = nrm((L, W_S, 2 * D_MODEL), W_S ** -0.5)
    inp['mla_q_norm'] = gain((L, Q_LORA))
    inp['mla_w_q_b'] = nrm((L, Q_LORA, MLA_HEADS * (QK_NOPE + QK_ROPE)), Q_LORA ** -0.5)
    inp['mla_kv_norm'] = gain((L, KV_LORA))
    inp['mla_w_kv_b'] = nrm((L, KV_LORA, MLA_HEADS * (QK_NOPE + V_DIM)), KV_LORA ** -0.5)
    inp['mla_w_o'] = nrm((L, MLA_HEADS * V_DIM, D_MODEL), (MLA_HEADS * V_DIM) ** -0.5)
    inp['hy_conv'] = nrm((L, 3, 3 * W_H), 3 ** -0.5)
    inp['hy_f_w1'] = nrm((L, HY_EMB, HY_FO), HY_EMB ** -0.5)
    inp['hy_f_b1'] = nrm((L, HY_FO), 0.1)
    inp['hy_f_w2'] = nrm((L, HY_FO, HY_FO), HY_FO ** -0.5)
    inp['hy_f_b2'] = nrm((L, HY_FO), 0.1)
    inp['hy_f_w3'] = nrm((L, HY_FO, HY_ORDER * 2 * W_H), HY_FO ** -0.5)
    inp['hy_f_freq'] = gain((L, HY_FO))
    inp['hy_bias'] = nrm((L, HY_ORDER, W_H), 0.5)
    inp['hy_w_out'] = nrm((L, W_H, D_MODEL), W_H ** -0.5)
    inp['w_mix_out'] = nrm((L, D_MODEL, D_MODEL), D_MODEL ** -0.5)
    inp['xa_norm'] = gain((L, D_MODEL))
    inp['mem_norm'] = gain((D_MODEL,))
    inp['xa_w_q'] = nrm((L, D_MODEL, XA_HEADS * XA_DH), D_MODEL ** -0.5)
    inp['xa_w_kv'] = nrm((L, D_MODEL, 2 * XA_HEADS * XA_DH), D_MODEL ** -0.5)
    inp['xa_w_o'] = nrm((L, XA_HEADS * XA_DH, D_MODEL), (XA_HEADS * XA_DH) ** -0.5)
    inp['moe_norm'] = gain((L, D_MODEL))
    inp['moe_w_group'] = nrm((L, D_MODEL, N_GROUPS), D_MODEL ** -0.5)
    inp['moe_b_group'] = nrm((L, N_GROUPS), 0.01)
    inp['moe_w_expert'] = nrm((L, D_MODEL, N_EXPERTS), D_MODEL ** -0.5)
    inp['moe_b_expert'] = nrm((L, N_EXPERTS), 0.01)
    inp['moe_w_gate'] = nrm((L, N_EXPERTS, D_MODEL, D_FF_E), D_MODEL ** -0.5)
    inp['moe_w_up'] = nrm((L, N_EXPERTS, D_MODEL, D_FF_E), D_MODEL ** -0.5)
    inp['moe_w_down'] = nrm((L, N_EXPERTS, D_FF_E, D_MODEL), D_FF_E ** -0.5)
    inp['final_norm'] = gain((D_MODEL,))
    return inp


def reference(x, mem, positions, mix_norm, w_in, gate_bias, conv_a, w_out_a,
              s5_lambda_re, s5_lambda_im, s5_log_step, s5_b_re, s5_b_im, s5_c_re, s5_c_im, s5_d, s5_w_glu,
              mla_q_norm, mla_w_q_b, mla_kv_norm, mla_w_kv_b, mla_w_o,
              hy_conv, hy_f_w1, hy_f_b1, hy_f_w2, hy_f_b2, hy_f_w3, hy_f_freq, hy_bias, hy_w_out,
              w_mix_out, xa_norm, mem_norm, xa_w_q, xa_w_kv, xa_w_o,
              moe_norm, moe_w_group, moe_b_group, moe_w_expert, moe_b_expert, moe_w_gate, moe_w_up, moe_w_down,
              final_norm):
    inv_freq = 1.0 / (ROPE_BASE ** (jnp.arange(0, QK_ROPE, 2, dtype=F32) / QK_ROPE))
    ang = positions.astype(F32)[..., None] * inv_freq
    cos = jnp.cos(ang).astype(x.dtype)
    sin = jnp.sin(ang).astype(x.dtype)
    mem_n = rmsnorm(mem, mem_norm)
    for l in range(DEPTH):
        h = rmsnorm(x, mix_norm[l])
        p_a, p_s, p_m, p_h, p_g = jnp.split(h @ w_in[l], IN_SPLITS, axis=-1)
        y_a = mixer_short_conv(p_a, conv_a[l], w_out_a[l])
        y_s = mixer_s5(p_s, s5_lambda_re[l], s5_lambda_im[l], s5_log_step[l], s5_b_re[l], s5_b_im[l],
                       s5_c_re[l], s5_c_im[l], s5_d[l], s5_w_glu[l])
        y_m = mixer_mla(p_m, cos, sin, mla_q_norm[l], mla_w_q_b[l], mla_kv_norm[l], mla_w_kv_b[l], mla_w_o[l])
        y_h = mixer_hyena(p_h, hy_conv[l], hy_f_w1[l], hy_f_b1[l], hy_f_w2[l], hy_f_b2[l], hy_f_w3[l],
                          hy_f_freq[l], hy_bias[l], hy_w_out[l])
        gates = jax.nn.sigmoid(p_g.reshape(p_g.shape[:-1] + (N_BRANCH, D_MODEL)) + gate_bias[l])
        merged = (gates[..., 0, :] * y_a + gates[..., 1, :] * y_s
                  + gates[..., 2, :] * y_m + gates[..., 3, :] * y_h)
        x = x + merged @ w_mix_out[l]
        x = x + cross_attention(rmsnorm(x, xa_norm[l]), mem_n, xa_w_q[l], xa_w_kv[l], xa_w_o[l])
        x = x + hier_moe(rmsnorm(x, moe_norm[l]), moe_w_group[l], moe_b_group[l], moe_w_expert[l],
                         moe_b_expert[l], moe_w_gate[l], moe_w_up[l], moe_w_down[l])
    return rmsnorm(x, final_norm)
```

```cpp
#include <hip/hip_runtime.h>
#include <stdint.h>
#include <stdio.h>

#ifndef MEGA
#define MEGA 1
#endif

#define DEVI __device__ __forceinline__
typedef unsigned short bf16_t;
typedef short bf16x8 __attribute__((ext_vector_type(8)));
typedef short s16x4 __attribute__((ext_vector_type(4)));
typedef float f32x4 __attribute__((ext_vector_type(4)));
typedef float f32x16 __attribute__((ext_vector_type(16)));
typedef unsigned u32x4 __attribute__((ext_vector_type(4)));
typedef unsigned u32x2 __attribute__((ext_vector_type(2)));

constexpr int T_ = 65536, SEQ = 4096, NBATCH = 16, DM = 1024, NIN = 8224;
constexpr int NTHR = 512;
constexpr float MLA_C = 0.10206207261596577f * 1.4426950408889634f;
constexpr float EPS = 1e-6f;

enum { I_X = 0, I_MEM, I_POS, I_MIXNORM, I_WIN, I_GATEB, I_CONVA, I_WOUTA, I_S5LRE, I_S5LIM, I_S5STEP, I_S5BRE, I_S5BIM,
       I_S5CRE, I_S5CIM, I_S5D, I_S5GLU, I_QNORM, I_WQB, I_KVNORM, I_WKVB, I_MLAWO, I_HYCONV, I_HYW1, I_HYB1, I_HYW2,
       I_HYB2, I_HYW3, I_HYFREQ, I_HYBIAS, I_HYWOUT, I_WMIX, I_XANORM, I_MEMNORM, I_XAWQ, I_XAWKV, I_XAWO, I_MOENORM,
       I_MOEWG, I_MOEBG, I_MOEWE, I_MOEBE, I_MOEGATE, I_MOEUP, I_MOEDOWN, I_FINALNORM, N_INPUTS };

struct Params { const void* in[N_INPUTS]; float* out; char* ws; };
template <class T> DEVI T* G(T* q) { return (T*)(__attribute__((address_space(1))) T*)q; }
#define INF(i) G((const float*)p.in[i])
#define OUTP G(p.out)
#define XB (G((bf16_t*)p.out) + 1024)
constexpr int XLD = 2048;

constexpr size_t MiB = 1ull << 20;
constexpr size_t OFF_BAR = 0;
constexpr size_t OFF_CNT = 64 * 1024;
constexpr size_t OFF_ONES = 128 * 1024;
constexpr size_t OFF_RSS = 167 * MiB;
constexpr size_t OFF_RSG = 589 * MiB;
constexpr size_t OFF_ROPE_C = 1 * MiB;
constexpr size_t OFF_ROPE_S = 5 * MiB;
constexpr size_t OFF_H2 = 9 * MiB;
constexpr size_t OFF_RTAB = 10 * MiB;
constexpr size_t OFF_MEMN = 26 * MiB;
constexpr size_t OFF_KVX = 34 * MiB;
constexpr size_t OFF_LOGIT = 42 * MiB;
constexpr size_t OFF_LIST = 58 * MiB;
constexpr size_t OFF_LISTW = 74 * MiB;
constexpr size_t OFF_W = 90 * MiB;
constexpr size_t OFF_H = 170 * MiB;
constexpr size_t OFF_PH = 298 * MiB;
constexpr size_t OFF_PA = 490 * MiB;
constexpr size_t OFF_PS = 682 * MiB;
constexpr size_t OFF_PM = 890 * MiB;
constexpr size_t OFF_ZA = 826 * MiB;
constexpr size_t OFF_CQN = 746 * MiB, OFF_CKVN = 778 * MiB, OFF_KR = 810 * MiB, OFF_Q = 558 * MiB;
constexpr size_t OFF_KV = 890 * MiB, OFF_O = 746 * MiB;
constexpr size_t OFF_YSF = 890 * MiB, OFF_YSB = 954 * MiB;
constexpr size_t OFF_VT = 490 * MiB, OFF_X1T = 554 * MiB, OFF_X2T = 618 * MiB;
constexpr size_t OFF_Z1T = 298 * MiB, OFF_ZT = 362 * MiB, OFF_Z = 426 * MiB;
constexpr size_t OFF_MERGED = 490 * MiB;
constexpr size_t OFF_YB = 618 * MiB;
constexpr size_t OFF_QX = 298 * MiB, OFF_OX = 362 * MiB;
constexpr size_t OFF_XG = 298 * MiB;
constexpr size_t OFF_WGT = 588 * MiB;
constexpr size_t OFF_YD = 298 * MiB;
constexpr size_t OFF_ROWIDX = 590 * MiB;
constexpr size_t OFF_HBUF = 600 * MiB;
constexpr size_t WS_NEED = 1024 * MiB;
#define WSB(off) G((bf16_t*)(p.ws + (off)))
#define WSF(off) G((float*)(p.ws + (off)))
#define WSP(T, off) G((T*)(p.ws + (off)))

constexpr size_t W_P = 0, W_G = W_P + 4352ull * 1024, W_OA = W_G + 4096ull * 1024, W_GLU = W_OA + 1024ull * 512, W_QB = W_GLU + 2048ull * 512,
                 W_KVB = W_QB + 768ull * 256, W_MO = W_KVB + 1024ull * 256, W_HO = W_MO + 1024ull * 512, W_MIX = W_HO + 1024ull * 512,
                 W_XQ = W_MIX + 1024ull * 1024, W_XKV = W_XQ + 512ull * 1024, W_XO = W_XKV + 1024ull * 1024, W_RT = W_XO + 1024ull * 512,
                 W_GU = W_RT + 256ull * 1024, W_D = W_GU + 32ull * 512 * 1024, W_END = W_D + 32ull * 1024 * 256;
static_assert(W_END * 2 <= 77 * MiB, "weight region overflow (row statistics live at +77 MiB)");
#define WW(o) (WSB(OFF_W) + (o))

constexpr int LDS_TAB = 131072;
constexpr int LDS_SQX = 131072 + 4096;
constexpr int LDS_TOTAL = 131072 + 4096 + 28672;

#if MEGA
constexpr int LDS_WID = 131072 + 3072;
DEVI int tidx() {
    extern __shared__ __attribute__((aligned(16))) char lds_dyn_[];
    const unsigned hw = (unsigned)__builtin_amdgcn_s_getreg((5 << 11) | 4) & 63u;
    const int w = __builtin_amdgcn_readfirstlane(*(const volatile __attribute__((address_space(3))) int*)(lds_dyn_ + LDS_WID + hw * 4));
    int t = (w << 6) | (int)__builtin_amdgcn_mbcnt_hi(~0u, __builtin_amdgcn_mbcnt_lo(~0u, 0u));
    asm volatile("" : "+v"(t)); return t;
}
#else
DEVI int tidx() { int t = threadIdx.x; asm volatile("" : "+v"(t)); return t; }
#endif
DEVI int bidx() { int b = blockIdx.x; asm volatile("" : "+s"(b)); return b; }
DEVI int gdim() { int g = gridDim.x; asm volatile("" : "+s"(g)); return g; }
typedef float f32x2 __attribute__((ext_vector_type(2)));
typedef __bf16 bf16x2n __attribute__((ext_vector_type(2)));
DEVI unsigned pk2(float lo, float hi) { const f32x2 v = {lo, hi}; const bf16x2n b = __builtin_convertvector(v, bf16x2n); return *(const unsigned*)&b; }
DEVI bf16_t f2bf(float v) { return (bf16_t)(pk2(v, 0.f) & 0xffffu); }
DEVI float bflo(unsigned x) { return __uint_as_float(x << 16); }
DEVI float bfhi(unsigned x) { return __uint_as_float(x & 0xffff0000u); }
DEVI float bf2f(bf16_t v) { return __uint_as_float(((unsigned)v) << 16); }
DEVI float wave_sum(float v) {
    const int lane = tidx() & 63;
#pragma unroll
    for (int m = 32; m; m >>= 1) v += __int_as_float(__builtin_amdgcn_ds_bpermute((lane ^ m) << 2, __float_as_int(v)));
    return v;
}
DEVI float sigmoid_(float x) { return __builtin_amdgcn_rcpf(1.f + __builtin_amdgcn_exp2f(-1.4426950408889634f * x)); }
DEVI float gelu_tanh(float x) {
    const float y = 0.7978845608028654f * (x + 0.044715f * x * x * x);
    const float e = __builtin_amdgcn_exp2f(2.8853900817779268f * y);
    return x * (1.f - __builtin_amdgcn_rcpf(1.f + e));
}
DEVI void unpack8(const bf16x8& v, float (&f)[8]) {
    const u32x4 w = *(const u32x4*)&v;
#pragma unroll
    for (int i = 0; i < 4; ++i) { f[2 * i] = bflo(w[i]); f[2 * i + 1] = bfhi(w[i]); }
}
DEVI bf16x8 pack8(const float (&f)[8]) {
    u32x4 w = {pk2(f[0], f[1]), pk2(f[2], f[3]), pk2(f[4], f[5]), pk2(f[6], f[7])};
    return *(bf16x8*)&w;
}
DEVI u32x2 pack4(f32x4 v) { u32x2 r = {pk2(v[0], v[1]), pk2(v[2], v[3])}; return r; }

#define XB_TMO      128
#define XB_XCNT(j)  (256  + 64 * (j))
#define XB_XSUB(j)  (1280 + 64 * (j))
#define XB_XGEN(j)  (2304 + 64 * (j))
#define XB_TOP      3328
#define XB_TOPGEN   3392
#define XCD_BAR_WORDS 3456
#define XB_SPIN_CAP (1u << 27)
#define LAS __attribute__((address_space(3)))

DEVI unsigned xb_ld(unsigned* p) { return __hip_atomic_load(p, __ATOMIC_RELAXED, __HIP_MEMORY_SCOPE_AGENT); }
DEVI unsigned xb_add(unsigned* p, unsigned v) { return __hip_atomic_fetch_add(p, v, __ATOMIC_RELAXED, __HIP_MEMORY_SCOPE_AGENT); }
DEVI unsigned xb_xcc_id() { return (unsigned)__builtin_amdgcn_s_getreg((3 << 11) | 20) & 0xFu; }
#define XB_SPIN(cond, bar) do { unsigned _sp = 0; while (cond) { __builtin_amdgcn_s_sleep(1); \
    if ((++_sp & 255u) == 0u) { if (xb_ld(&(bar)[XB_TMO])) break; if (_sp > XB_SPIN_CAP) { atomicAdd(&(bar)[XB_TMO], 1u); break; } } } } while (0)

struct XcdBarrier { unsigned* bar; unsigned x; volatile LAS unsigned* st; };

DEVI XcdBarrier xcd_barrier_post(unsigned* bar, volatile LAS unsigned* st) {
    XcdBarrier b; b.bar = bar; b.x = xb_xcc_id(); b.st = st;
    if (threadIdx.x == 0) (void)xb_add(&bar[XB_XCNT(b.x)], 1u);
    return b;
}
DEVI void xcd_barrier_complete(unsigned* bar, unsigned x, unsigned& nloc, unsigned& nx) {
    const unsigned G = gridDim.x * gridDim.y * gridDim.z;
    unsigned sum, cnt, mine, sp = 0u;
    for (;;) {
        sum = 0u; cnt = 0u; mine = 0u;
#pragma unroll
        for (unsigned j = 0; j < 16; ++j) { const unsigned c = xb_ld(&bar[XB_XCNT(j)]); sum += c; cnt += (c > 0u) ? 1u : 0u; mine = (j == x) ? c : mine; }
        if (sum == G) break;
        __builtin_amdgcn_s_sleep(1);
        if ((++sp & 255u) == 0u) { if (xb_ld(&bar[XB_TMO])) break; if (sp > XB_SPIN_CAP) { atomicAdd(&bar[XB_TMO], 1u); break; } }
    }
    nloc = mine > 0u ? mine : 1u; nx = cnt > 0u ? cnt : 1u;
}
DEVI void xcd_barrier(const XcdBarrier& b) {
    asm volatile("s_waitcnt vmcnt(0)" ::: "memory");
    __syncthreads();
    if (tidx() == 0) {
        unsigned* bar = b.bar; asm volatile("" : "+s"(bar));
        unsigned bx = b.x; asm volatile("" : "+s"(bx));
        __builtin_amdgcn_s_waitcnt(0);
        unsigned nloc = b.st[0], nx = b.st[1];
        if (nloc == 0u) { xcd_barrier_complete(bar, bx, nloc, nx); b.st[0] = nloc; b.st[1] = nx; }
        const unsigned old = xb_add(&bar[XB_XSUB(bx)], 1u);
        const unsigned gen = old / nloc;
        if (old + 1u == (gen + 1u) * nloc) {
            __builtin_amdgcn_fence(__ATOMIC_RELEASE, "agent");
            asm volatile("s_waitcnt vmcnt(0)" ::: "memory");
            const unsigned og = xb_add(&bar[XB_TOP], 1u);
            const unsigned tg = og / nx;
            if (og + 1u == (tg + 1u) * nx) xb_add(&bar[XB_TOPGEN], 1u);
            else XB_SPIN(xb_ld(&bar[XB_TOPGEN]) == tg, bar);
            __builtin_amdgcn_fence(__ATOMIC_ACQUIRE, "agent");
            xb_add(&bar[XB_XGEN(bx)], 1u);
            asm volatile("s_waitcnt vmcnt(0)" ::: "memory");
        } else {
            XB_SPIN(xb_ld(&bar[XB_XGEN(bx)]) == gen, bar);
            __builtin_amdgcn_fence(__ATOMIC_ACQUIRE, "agent");
            asm volatile("s_waitcnt vmcnt(0)" ::: "memory");
        }
    }
    __syncthreads();
}

constexpr int GBM = 256, GBN = 128, GBK = 64, GLD = 72;
constexpr int G_AS = GBM * GLD * 2, G_BS = GBN * GLD * 2;
template <int NF, class AL, class BL>
DEVI void gemm_kloop_t(f32x4 (&acc)[4][NF], const AL& al, const BL& bl, int K, char* lds) {
    const int tid = tidx(), lane = tid & 63, wid = tid >> 6, wm = wid >> 1, wn = wid & 1;
    bf16_t* As = (bf16_t*)lds; bf16_t* Bs = (bf16_t*)(lds + 2 * G_AS);
    const int srow = tid >> 3, sch = (tid & 7) * 8;
    constexpr int NBL = NF / 2;
    bf16x8 ra[4], rb[NBL];
#define G_LOAD(kk) do { _Pragma("unroll") for (int i = 0; i < 4; ++i) ra[i] = al(i, srow + 64 * i, (kk) + sch); \
                        _Pragma("unroll") for (int i = 0; i < NBL; ++i) rb[i] = bl(i, srow + 64 * i, (kk) + sch); } while (0)
#define G_STORE(buf) do { bf16_t* An_ = As + (buf) * (GBM * GLD); bf16_t* Bn_ = Bs + (buf) * (GBN * GLD); \
                        _Pragma("unroll") for (int i = 0; i < 4; ++i) *(bf16x8*)(An_ + (srow + 64 * i) * GLD + sch) = ra[i]; \
                        _Pragma("unroll") for (int i = 0; i < NBL; ++i) *(bf16x8*)(Bn_ + (srow + 64 * i) * GLD + sch) = rb[i]; } while (0)
    const int nk = K / GBK;
    G_LOAD(0);
    __syncthreads();
    G_STORE(0);
    if (nk > 1) G_LOAD(GBK);
    __syncthreads();
    const int aoff = (wm * 64 + (lane & 15)) * GLD + 8 * (lane >> 4);
    const int boff = (wn * NF * 16 + (lane & 15)) * GLD + 8 * (lane >> 4);
    for (int kt = 0; kt < nk; ++kt) {
        const int cur = kt & 1;
        const bf16_t* Ab = As + cur * (GBM * GLD) + aoff;
        const bf16_t* Bb = Bs + cur * (GBN * GLD) + boff;
#pragma unroll
        for (int ks = 0; ks < 2; ++ks) {
            bf16x8 af[4], bfr[NF];
#pragma unroll
            for (int m = 0; m < 4; ++m) af[m] = *(const bf16x8*)(Ab + m * 16 * GLD + ks * 32);
#pragma unroll
            for (int n = 0; n < NF; ++n) bfr[n] = *(const bf16x8*)(Bb + n * 16 * GLD + ks * 32);
#pragma unroll
            for (int m = 0; m < 4; ++m)
#pragma unroll
                for (int n = 0; n < NF; ++n) acc[m][n] = __builtin_amdgcn_mfma_f32_16x16x32_bf16(bfr[n], af[m], acc[m][n], 0, 0, 0);
            if (ks == 0) {
                __builtin_amdgcn_sched_barrier(0);
                if (kt + 1 < nk) { G_STORE(cur ^ 1); if (kt + 2 < nk) G_LOAD((kt + 2) * GBK); }
                __builtin_amdgcn_sched_barrier(0);
            }
        }
        __syncthreads();
    }
#undef G_LOAD
#undef G_STORE
}
template <class AL, class BL>
DEVI void gemm_kloop(f32x4 (&acc)[4][4], const AL& al, const BL& bl, int K, char* lds) { gemm_kloop_t<4>(acc, al, bl, K, lds); }
struct RowLoader {
    const bf16_t* base; int ld;
    DEVI bf16x8 operator()(int, int r, int k) const { return *(const bf16x8*)(base + (size_t)r * ld + k); }
};
template <int NF>
DEVI void zero_acc(f32x4 (&acc)[4][NF]) {
#pragma unroll
    for (int m = 0; m < 4; ++m)
#pragma unroll
        for (int n = 0; n < NF; ++n) acc[m][n] = (f32x4){0.f, 0.f, 0.f, 0.f};
}


namespace pg8 {
#define PG8_LAS __attribute__((address_space(3)))
constexpr int BM = 256, BK = 64, HALF = 128, HTB = HALF * BK * 2, STAGE_BYTES = 8 * HTB, NXCD = 8, WGM = 8;
DEVI int lds_byte(int r, int c) { const int st = (r >> 4) * 2 + (c >> 5), rr = r & 15, cc = c & 31, ob = rr * 64 + cc * 2; return st * 1024 + (ob ^ (((ob >> 9) & 1) << 5)); }
DEVI void stage_rc(int b, int& R, int& C) { const int st = b / 1024, sb = b % 1024, swz = sb ^ (((sb >> 9) & 1) << 5); R = (st >> 1) * 16 + swz / 64; C = (st & 1) * 32 + (swz % 64) / 2; }
DEVI int perm32(int rho) { const int n = rho >> 4, i = rho & 15; return 8 * (i >> 2) + 4 * n + (i & 3); }
struct Unit { int pm, pn; };
struct Gemm { const bf16_t* A; const bf16_t* Bt; int M, N, K; int lda = 0; };
struct StaticOrder {
    int nM, nN, nwg, G, c;
    DEVI void init(int M, int N, int G_, int c_) { nM = M / BM; nN = N / BM; nwg = nM * nN; G = G_; c = c_; }
    DEVI bool next(int i, Unit& u) const {
        const long L = (long)i * G + c; if (L >= nwg) return false;
        int wgid = (int)L; { const int q = nwg / NXCD, r = nwg % NXCD, xcd = wgid % NXCD, off = wgid / NXCD; wgid = (xcd < r ? xcd * (q + 1) : r * (q + 1) + (xcd - r) * q) + off; }
        const int nig = WGM * nN, gid = wgid / nig, fm = gid * WGM, gsz = (nM - fm) < WGM ? (nM - fm) : WGM;
        u.pm = fm + ((wgid % nig) % gsz); u.pn = (wgid % nig) / gsz; return true;
    }
    DEVI void a_ready(const Unit&) const {}
    DEVI void done(const Unit&) const {}
};
struct RowPanelOrder {
    int nM, nN, G, c;
    DEVI void init(int M, int N, int G_, int c_) { nM = M / BM; nN = N / BM; G = G_; c = c_; }
    DEVI bool next(int i, Unit& u) const { const int pm = c + G * (i / nN); if (pm >= nM) return false; u.pm = pm; u.pn = i % nN; return true; }
    DEVI void a_ready(const Unit&) const {}
    DEVI void done(const Unit&) const {}
};
template <class Epi, class Sched>
DEVI void gemm_phase(char* lds_generic, const Gemm g, const Sched& S, const Epi& E) {
    PG8_LAS unsigned char* lds = (PG8_LAS unsigned char*)lds_generic;
    const int tid = tidx(), wid = __builtin_amdgcn_readfirstlane(tid >> 6), lane = tid & 63, wr = wid >> 2, wc = wid & 3, fr = lane & 15, fq = lane >> 4;
    const int K = g.K, nt = K / BK, lda = g.lda ? g.lda : K;
    unsigned voffA[2], voffB[2];
#pragma unroll
    for (int i = 0; i < 2; ++i) { int R, C; stage_rc(tid * 16 + i * 8192, R, C); const int Rb = Epi::PERM ? ((R & ~31) + perm32(R & 31)) : R;
        voffA[i] = (unsigned)(R * lda + C) * 2u; voffB[i] = (unsigned)(Rb * K + C) * 2u; }
    const size_t kstep = (size_t)(BK * 2);
    const size_t hstep = (size_t)HALF * K * 2, hstepA = (size_t)HALF * lda * 2;
    const size_t tstep = 2 * hstep, tstepA = 2 * hstepA;
    const unsigned ldsw = (unsigned)wid * 1024u;
    const int aoff = lds_byte(wr * 64 + fr, fq * 8), boff = lds_byte(wc * 32 + fr, fq * 8);
#define PG8_SA(b, h) (((b) * 2 + (h)) * HTB)
#define PG8_SB(b, h) ((4 + (b) * 2 + (h)) * HTB)
#define PG8_STAGE(bufoff, gbase, voff) do { _Pragma("unroll") for (int _i = 0; _i < 2; ++_i) \
        __builtin_amdgcn_global_load_lds((const unsigned*)((const char*)(gbase) + (voff)[_i]), (PG8_LAS unsigned*)(lds + (bufoff) + ldsw + _i * 8192), 16, 0, 0); } while (0)
#define PG8_LDA(dst, b, h) do { _Pragma("unroll") for (int m = 0; m < 4; ++m) _Pragma("unroll") for (int k = 0; k < 2; ++k) dst[m][k] = *(const PG8_LAS bf16x8*)(lds + PG8_SA(b, h) + aoff + m * 2048 + k * 1024); } while (0)
#define PG8_LDB(dst, b, h) do { _Pragma("unroll") for (int n = 0; n < 2; ++n) _Pragma("unroll") for (int k = 0; k < 2; ++k) dst[n][k] = *(const PG8_LAS bf16x8*)(lds + PG8_SB(b, h) + boff + n * 2048 + k * 1024); } while (0)
#define PG8_MMA(ai, bj, At, Bt) do { __builtin_amdgcn_s_setprio(1); _Pragma("unroll") for (int m = 0; m < 4; ++m) _Pragma("unroll") for (int n = 0; n < 2; ++n) _Pragma("unroll") for (int k = 0; k < 2; ++k) \
        acc[ai][bj][m][n] = __builtin_amdgcn_mfma_f32_16x16x32_bf16(Bt[n][k], At[m][k], acc[ai][bj][m][n], 0, 0, 0); __builtin_amdgcn_s_setprio(0); } while (0)
#define PG8_WAIT_V(n) asm volatile("s_waitcnt vmcnt(" #n ")" ::: "memory")
#define PG8_WAIT_L(n) asm volatile("s_waitcnt lgkmcnt(" #n ")" ::: "memory")
#define PG8_BAR __builtin_amdgcn_s_barrier()
#define PG8_SCHED __builtin_amdgcn_sched_barrier(0)
    __syncthreads();
    Unit cur, nxt; int ui = 0;
    if (!S.next(0, cur)) return;
    f32x4 acc[2][2][4][2];
#pragma unroll
    for (int a = 0; a < 2; ++a)
#pragma unroll
        for (int b = 0; b < 2; ++b)
#pragma unroll
            for (int m = 0; m < 4; ++m)
#pragma unroll
                for (int n = 0; n < 2; ++n) acc[a][b][m][n] = (f32x4){0.f, 0.f, 0.f, 0.f};
    bf16x8 At[4][2], B0[2][2], B1[2][2];
    const char* cA = (const char*)g.A + (size_t)cur.pm * tstepA; const char* cB = (const char*)g.Bt + (size_t)cur.pn * tstep;
    S.a_ready(cur);
    PG8_STAGE(PG8_SB(0, 0), cB, voffB); PG8_STAGE(PG8_SA(0, 0), cA, voffA); PG8_STAGE(PG8_SB(0, 1), cB + hstep, voffB); PG8_STAGE(PG8_SA(0, 1), cA + hstepA, voffA);
    if (wr == 1) PG8_BAR;
    PG8_WAIT_V(4); PG8_BAR;
    PG8_STAGE(PG8_SB(1, 0), cB + kstep, voffB); PG8_STAGE(PG8_SA(1, 0), cA + kstep, voffA); PG8_STAGE(PG8_SB(1, 1), cB + hstep + kstep, voffB);
    PG8_WAIT_V(6); PG8_BAR;
    for (;;) {
        const bool has_next = S.next(ui + 1, nxt);
        const char* nA = has_next ? (const char*)g.A + (size_t)nxt.pm * tstepA : cA; const char* nB = has_next ? (const char*)g.Bt + (size_t)nxt.pn * tstep : cB;
        for (int t = 0; t < nt; t += 2) {
            const bool last = (t == nt - 2);
            const char* a1 = cA + (size_t)(t + 1) * kstep;
            const char* a2 = last ? nA : cA + (size_t)(t + 2) * kstep; const char* b2 = last ? nB : cB + (size_t)(t + 2) * kstep;
            const char* a3 = a2 + kstep; const char* b3 = b2 + kstep;
            if (last && has_next) S.a_ready(nxt);
            PG8_LDB(B0, 0, 0); PG8_SCHED; PG8_LDA(At, 0, 0); PG8_STAGE(PG8_SA(1, 1), a1 + hstepA, voffA);
            PG8_WAIT_L(8); PG8_BAR; PG8_WAIT_L(0); PG8_MMA(0, 0, At, B0); PG8_BAR; PG8_SCHED;
            PG8_LDB(B1, 0, 1); PG8_STAGE(PG8_SB(0, 0), b2, voffB);
            PG8_BAR; PG8_WAIT_L(0); PG8_MMA(0, 1, At, B1); PG8_BAR;
            PG8_LDA(At, 0, 1); PG8_STAGE(PG8_SA(0, 0), a2, voffA);
            PG8_BAR; PG8_WAIT_L(0); PG8_MMA(1, 0, At, B0); PG8_BAR; PG8_SCHED;
            PG8_STAGE(PG8_SB(0, 1), b2 + hstep, voffB);
            PG8_WAIT_V(6); PG8_BAR; PG8_MMA(1, 1, At, B1); PG8_BAR;
            PG8_LDB(B0, 1, 0); PG8_SCHED; PG8_LDA(At, 1, 0); PG8_STAGE(PG8_SA(0, 1), a2 + hstepA, voffA);
            PG8_WAIT_L(8); PG8_BAR; PG8_WAIT_L(0); PG8_MMA(0, 0, At, B0); PG8_BAR; PG8_SCHED;
            PG8_LDB(B1, 1, 1); PG8_STAGE(PG8_SB(1, 0), b3, voffB);
            PG8_BAR; PG8_WAIT_L(0); PG8_MMA(0, 1, At, B1); PG8_BAR;
            PG8_LDA(At, 1, 1); PG8_STAGE(PG8_SA(1, 0), a3, voffA);
            PG8_BAR; PG8_WAIT_L(0); PG8_MMA(1, 0, At, B0); PG8_BAR; PG8_SCHED;
            PG8_STAGE(PG8_SB(1, 1), b3 + hstep, voffB);
            PG8_WAIT_V(6); PG8_BAR; PG8_MMA(1, 1, At, B1); PG8_BAR;
        }
        E(acc, cur, wr, wc, fr, fq); S.done(cur);
        if (!has_next) break;
#pragma unroll
        for (int a = 0; a < 2; ++a)
#pragma unroll
            for (int b = 0; b < 2; ++b)
#pragma unroll
                for (int m = 0; m < 4; ++m)
#pragma unroll
                    for (int n = 0; n < 2; ++n) acc[a][b][m][n] = (f32x4){0.f, 0.f, 0.f, 0.f};
        cur = nxt; cA = nA; cB = nB; ++ui;
    }
    PG8_WAIT_V(0);
    if (wr == 0) PG8_BAR;
    PG8_BAR;
#undef PG8_SA
#undef PG8_SB
#undef PG8_STAGE
#undef PG8_LDA
#undef PG8_LDB
#undef PG8_MMA
#undef PG8_WAIT_V
#undef PG8_WAIT_L
#undef PG8_BAR
#undef PG8_SCHED
}
template <class Epi, class Sched>
DEVI void gemm_phase2(char* lds_generic, const Gemm g0, const Gemm g1, const Sched& S, const Epi& E) {
    PG8_LAS unsigned char* lds = (PG8_LAS unsigned char*)lds_generic;
    const int tid = tidx(), wid = __builtin_amdgcn_readfirstlane(tid >> 6), lane = tid & 63, wr = wid >> 2, wc = wid & 3, fr = lane & 15, fq = lane >> 4;
    const int K0 = g0.K, K1 = g1.K, nt0 = K0 / BK, nt1 = K1 / BK, lda0 = g0.lda ? g0.lda : K0, lda1 = g1.lda ? g1.lda : K1;
    unsigned R2[2], Rb2[2], C2[2];
#pragma unroll
    for (int i = 0; i < 2; ++i) { int R, C; stage_rc(tid * 16 + i * 8192, R, C); const int Rb = Epi::PERM ? ((R & ~31) + perm32(R & 31)) : R;
        R2[i] = (unsigned)R * 2u; Rb2[i] = (unsigned)Rb * 2u; C2[i] = (unsigned)C * 2u; }
    const size_t kstep = (size_t)(BK * 2);
    const unsigned ldsw = (unsigned)wid * 1024u;
    const int aoff = lds_byte(wr * 64 + fr, fq * 8), boff = lds_byte(wc * 32 + fr, fq * 8);
#define PG8_SA(b, h) (((b) * 2 + (h)) * HTB)
#define PG8_SB(b, h) ((4 + (b) * 2 + (h)) * HTB)
#define PG8_STAGE(bufoff, gbase, RR, ld) do { _Pragma("unroll") for (int _i = 0; _i < 2; ++_i) \
        __builtin_amdgcn_global_load_lds((const unsigned*)((const char*)(gbase) + (RR[_i] * (unsigned)(ld) + C2[_i])), (PG8_LAS unsigned*)(lds + (bufoff) + ldsw + _i * 8192), 16, 0, 0); } while (0)
#define PG8_LDA(dst, b, h) do { _Pragma("unroll") for (int m = 0; m < 4; ++m) _Pragma("unroll") for (int k = 0; k < 2; ++k) dst[m][k] = *(const PG8_LAS bf16x8*)(lds + PG8_SA(b, h) + aoff + m * 2048 + k * 1024); } while (0)
#define PG8_LDB(dst, b, h) do { _Pragma("unroll") for (int n = 0; n < 2; ++n) _Pragma("unroll") for (int k = 0; k < 2; ++k) dst[n][k] = *(const PG8_LAS bf16x8*)(lds + PG8_SB(b, h) + boff + n * 2048 + k * 1024); } while (0)
#define PG8_MMA(ai, bj, At, Bt) do { __builtin_amdgcn_s_setprio(1); _Pragma("unroll") for (int m = 0; m < 4; ++m) _Pragma("unroll") for (int n = 0; n < 2; ++n) _Pragma("unroll") for (int k = 0; k < 2; ++k) \
        acc[ai][bj][m][n] = __builtin_amdgcn_mfma_f32_16x16x32_bf16(Bt[n][k], At[m][k], acc[ai][bj][m][n], 0, 0, 0); __builtin_amdgcn_s_setprio(0); } while (0)
#define PG8_WAIT_V(n) asm volatile("s_waitcnt vmcnt(" #n ")" ::: "memory")
#define PG8_WAIT_L(n) asm volatile("s_waitcnt lgkmcnt(" #n ")" ::: "memory")
#define PG8_BAR __builtin_amdgcn_s_barrier()
#define PG8_SCHED __builtin_amdgcn_sched_barrier(0)
    __syncthreads();
    Unit cur, nxt; int ui = 0;
    if (!S.next(0, cur)) return;
    f32x4 acc[2][2][4][2];
#pragma unroll
    for (int a = 0; a < 2; ++a)
#pragma unroll
        for (int b = 0; b < 2; ++b)
#pragma unroll
            for (int m = 0; m < 4; ++m)
#pragma unroll
                for (int n = 0; n < 2; ++n) acc[a][b][m][n] = (f32x4){0.f, 0.f, 0.f, 0.f};
    bf16x8 At[4][2], B0[2][2], B1[2][2];
    const char* cA = (const char*)g0.A + (size_t)cur.pm * (size_t)(2 * HALF) * lda0 * 2; const char* cB = (const char*)g0.Bt + (size_t)cur.pn * (size_t)(2 * HALF) * K0 * 2;
    { const size_t hB = (size_t)HALF * K0 * 2, hA = (size_t)HALF * lda0 * 2;
      PG8_STAGE(PG8_SB(0, 0), cB, Rb2, K0); PG8_STAGE(PG8_SA(0, 0), cA, R2, lda0); PG8_STAGE(PG8_SB(0, 1), cB + hB, Rb2, K0); PG8_STAGE(PG8_SA(0, 1), cA + hA, R2, lda0);
      if (wr == 1) PG8_BAR;
      PG8_WAIT_V(4); PG8_BAR;
      PG8_STAGE(PG8_SB(1, 0), cB + kstep, Rb2, K0); PG8_STAGE(PG8_SA(1, 0), cA + kstep, R2, lda0); PG8_STAGE(PG8_SB(1, 1), cB + hB + kstep, Rb2, K0);
      PG8_WAIT_V(6); PG8_BAR; }
    for (;;) {
        const int st = ui & 1;
        bool has_next; const char* nA; const char* nB;
        if (st == 0) { has_next = true; nxt = cur; nA = (const char*)g1.A + (size_t)cur.pm * (size_t)(2 * HALF) * lda1 * 2; nB = (const char*)g1.Bt + (size_t)cur.pn * (size_t)(2 * HALF) * K1 * 2; }
        else { has_next = S.next((ui + 1) >> 1, nxt);
               nA = has_next ? (const char*)g0.A + (size_t)nxt.pm * (size_t)(2 * HALF) * lda0 * 2 : cA; nB = has_next ? (const char*)g0.Bt + (size_t)nxt.pn * (size_t)(2 * HALF) * K0 * 2 : cB; }
        const int nt = st ? nt1 : nt0, ldAc = st ? lda1 : lda0, ldBc = st ? K1 : K0, ldAn = st ? lda0 : lda1, ldBn = st ? K0 : K1;
        const size_t hAc = (size_t)HALF * ldAc * 2;
        for (int t = 0; t < nt; t += 2) {
            const bool last = (t == nt - 2);
            const char* a1 = cA + (size_t)(t + 1) * kstep;
            const char* a2 = last ? nA : cA + (size_t)(t + 2) * kstep; const char* b2 = last ? nB : cB + (size_t)(t + 2) * kstep;
            const char* a3 = a2 + kstep; const char* b3 = b2 + kstep;
            const int ldA2 = last ? ldAn : ldAc, ldB2 = last ? ldBn : ldBc;
            const size_t hA2 = (size_t)HALF * ldA2 * 2, hB2 = (size_t)HALF * ldB2 * 2;
            PG8_LDB(B0, 0, 0); PG8_SCHED; PG8_LDA(At, 0, 0); PG8_STAGE(PG8_SA(1, 1), a1 + hAc, R2, ldAc);
            PG8_WAIT_L(8); PG8_BAR; PG8_WAIT_L(0); PG8_MMA(0, 0, At, B0); PG8_BAR; PG8_SCHED;
            PG8_LDB(B1, 0, 1); PG8_STAGE(PG8_SB(0, 0), b2, Rb2, ldB2);
            PG8_BAR; PG8_WAIT_L(0); PG8_MMA(0, 1, At, B1); PG8_BAR;
            PG8_LDA(At, 0, 1); PG8_STAGE(PG8_SA(0, 0), a2, R2, ldA2);
            PG8_BAR; PG8_WAIT_L(0); PG8_MMA(1, 0, At, B0); PG8_BAR; PG8_SCHED;
            PG8_STAGE(PG8_SB(0, 1), b2 + hB2, Rb2, ldB2);
            PG8_WAIT_V(6); PG8_BAR; PG8_MMA(1, 1, At, B1); PG8_BAR;
            PG8_LDB(B0, 1, 0); PG8_SCHED; PG8_LDA(At, 1, 0); PG8_STAGE(PG8_SA(0, 1), a2 + hA2, R2, ldA2);
            PG8_WAIT_L(8); PG8_BAR; PG8_WAIT_L(0); PG8_MMA(0, 0, At, B0); PG8_BAR; PG8_SCHED;
            PG8_LDB(B1, 1, 1); PG8_STAGE(PG8_SB(1, 0), b3, Rb2, ldB2);
            PG8_BAR; PG8_WAIT_L(0); PG8_MMA(0, 1, At, B1); PG8_BAR;
            PG8_LDA(At, 1, 1); PG8_STAGE(PG8_SA(1, 0), a3, R2, ldA2);
            PG8_BAR; PG8_WAIT_L(0); PG8_MMA(1, 0, At, B0); PG8_BAR; PG8_SCHED;
            PG8_STAGE(PG8_SB(1, 1), b3 + hB2, Rb2, ldB2);
            PG8_WAIT_V(6); PG8_BAR; PG8_MMA(1, 1, At, B1); PG8_BAR;
        }
        E(acc, cur, st, wr, wc, fr, fq);
        if (!has_next) break;
#pragma unroll
        for (int a = 0; a < 2; ++a)
#pragma unroll
            for (int b = 0; b < 2; ++b)
#pragma unroll
                for (int m = 0; m < 4; ++m)
#pragma unroll
                    for (int n = 0; n < 2; ++n) acc[a][b][m][n] = (f32x4){0.f, 0.f, 0.f, 0.f};
        cur = nxt; cA = nA; cB = nB; ++ui;
    }
    PG8_WAIT_V(0);
    if (wr == 0) PG8_BAR;
    PG8_BAR;
#undef PG8_SA
#undef PG8_SB
#undef PG8_STAGE
#undef PG8_LDA
#undef PG8_LDB
#undef PG8_MMA
#undef PG8_WAIT_V
#undef PG8_WAIT_L
#undef PG8_BAR
#undef PG8_SCHED
}
template <class Epi, class Sched, class Desc>
DEVI void gemm_phaseN(char* lds_generic, const Desc& D, const Sched& S, const Epi& E) {
    PG8_LAS unsigned char* lds = (PG8_LAS unsigned char*)lds_generic;
    const int tid = tidx(), wid = __builtin_amdgcn_readfirstlane(tid >> 6), lane = tid & 63, wr = wid >> 2, wc = wid & 3, fr = lane & 15, fq = lane >> 4;
    unsigned R2[2], Rb2[2], C2[2];
#pragma unroll
    for (int i = 0; i < 2; ++i) { int R, C; stage_rc(tid * 16 + i * 8192, R, C); const int Rb = Epi::PERM ? ((R & ~31) + perm32(R & 31)) : R;
        R2[i] = (unsigned)R * 2u; Rb2[i] = (unsigned)Rb * 2u; C2[i] = (unsigned)C * 2u; }
    const size_t kstep = (size_t)(BK * 2);
    const unsigned ldsw = (unsigned)wid * 1024u;
    const int aoff = lds_byte(wr * 64 + fr, fq * 8), boff = lds_byte(wc * 32 + fr, fq * 8);
#define PG8_SA(b, h) (((b) * 2 + (h)) * HTB)
#define PG8_SB(b, h) ((4 + (b) * 2 + (h)) * HTB)
#define PG8_STAGE(bufoff, gbase, RR, ld) do { _Pragma("unroll") for (int _i = 0; _i < 2; ++_i) \
        __builtin_amdgcn_global_load_lds((const unsigned*)((const char*)(gbase) + (RR[_i] * (unsigned)(ld) + C2[_i])), (PG8_LAS unsigned*)(lds + (bufoff) + ldsw + _i * 8192), 16, 0, 0); } while (0)
#define PG8_LDA(dst, b, h) do { _Pragma("unroll") for (int m = 0; m < 4; ++m) _Pragma("unroll") for (int k = 0; k < 2; ++k) dst[m][k] = *(const PG8_LAS bf16x8*)(lds + PG8_SA(b, h) + aoff + m * 2048 + k * 1024); } while (0)
#define PG8_LDB(dst, b, h) do { _Pragma("unroll") for (int n = 0; n < 2; ++n) _Pragma("unroll") for (int k = 0; k < 2; ++k) dst[n][k] = *(const PG8_LAS bf16x8*)(lds + PG8_SB(b, h) + boff + n * 2048 + k * 1024); } while (0)
#define PG8_MMA(ai, bj, At, Bt) do { __builtin_amdgcn_s_setprio(1); _Pragma("unroll") for (int m = 0; m < 4; ++m) _Pragma("unroll") for (int n = 0; n < 2; ++n) _Pragma("unroll") for (int k = 0; k < 2; ++k) \
        acc[ai][bj][m][n] = __builtin_amdgcn_mfma_f32_16x16x32_bf16(Bt[n][k], At[m][k], acc[ai][bj][m][n], 0, 0, 0); __builtin_amdgcn_s_setprio(0); } while (0)
#define PG8_WAIT_V(n) asm volatile("s_waitcnt vmcnt(" #n ")" ::: "memory")
#define PG8_WAIT_L(n) asm volatile("s_waitcnt lgkmcnt(" #n ")" ::: "memory")
#define PG8_BAR __builtin_amdgcn_s_barrier()
#define PG8_SCHED __builtin_amdgcn_sched_barrier(0)
    __syncthreads();
    const char* A0_; const char* B0_; int K0, lda0, bm0, ba0; D.get(0, A0_, B0_, K0, lda0, bm0, ba0);
    Unit cur, nxt; int ti = 0, st = 0;
    if (!S.next(0, cur)) return;
    f32x4 acc[2][2][4][2];
#pragma unroll
    for (int a = 0; a < 2; ++a)
#pragma unroll
        for (int b = 0; b < 2; ++b)
#pragma unroll
            for (int m = 0; m < 4; ++m)
#pragma unroll
                for (int n = 0; n < 2; ++n) acc[a][b][m][n] = (f32x4){0.f, 0.f, 0.f, 0.f};
    bf16x8 At[4][2], B0[2][2], B1[2][2];
    const char* cA = A0_ + (size_t)cur.pm * (size_t)(2 * HALF) * lda0 * 2; const char* cB = B0_ + (size_t)(cur.pn * bm0 + ba0) * (size_t)(2 * HALF) * K0 * 2;
    { const size_t hB = (size_t)HALF * K0 * 2, hA = (size_t)HALF * lda0 * 2;
      PG8_STAGE(PG8_SB(0, 0), cB, Rb2, K0); PG8_STAGE(PG8_SA(0, 0), cA, R2, lda0); PG8_STAGE(PG8_SB(0, 1), cB + hB, Rb2, K0); PG8_STAGE(PG8_SA(0, 1), cA + hA, R2, lda0);
      if (wr == 1) PG8_BAR;
      PG8_WAIT_V(4); PG8_BAR;
      PG8_STAGE(PG8_SB(1, 0), cB + kstep, Rb2, K0); PG8_STAGE(PG8_SA(1, 0), cA + kstep, R2, lda0); PG8_STAGE(PG8_SB(1, 1), cB + hB + kstep, Rb2, K0);
      PG8_WAIT_V(6); PG8_BAR; }
    for (;;) {
        const int sn = (st + 1 == Desc::NS) ? 0 : st + 1;
        bool has_next = true; nxt = cur;
        if (sn == 0) has_next = S.next(ti + 1, nxt);
        const char* Ac_; const char* Bc_; int Kc, ldAc, bmc, bac; D.get(st, Ac_, Bc_, Kc, ldAc, bmc, bac);
        const char* An_; const char* Bn_; int Kn, ldAn, bmn, ban; D.get(sn, An_, Bn_, Kn, ldAn, bmn, ban);
        const char* nA = has_next ? An_ + (size_t)nxt.pm * (size_t)(2 * HALF) * ldAn * 2 : cA; const char* nB = has_next ? Bn_ + (size_t)(nxt.pn * bmn + ban) * (size_t)(2 * HALF) * Kn * 2 : cB;
        const int nt = Kc / BK, ldBc = Kc, ldBn = Kn;
        const size_t hAc = (size_t)HALF * ldAc * 2;
        for (int t = 0; t < nt; t += 2) {
            const bool last = (t == nt - 2);
            const char* a1 = cA + (size_t)(t + 1) * kstep;
            const char* a2 = last ? nA : cA + (size_t)(t + 2) * kstep; const char* b2 = last ? nB : cB + (size_t)(t + 2) * kstep;
            const char* a3 = a2 + kstep; const char* b3 = b2 + kstep;
            const int ldA2 = last ? ldAn : ldAc, ldB2 = last ? ldBn : ldBc;
            const size_t hA2 = (size_t)HALF * ldA2 * 2, hB2 = (size_t)HALF * ldB2 * 2;
            PG8_LDB(B0, 0, 0); PG8_SCHED; PG8_LDA(At, 0, 0); PG8_STAGE(PG8_SA(1, 1), a1 + hAc, R2, ldAc);
            PG8_WAIT_L(8); PG8_BAR; PG8_WAIT_L(0); PG8_MMA(0, 0, At, B0); PG8_BAR; PG8_SCHED;
            PG8_LDB(B1, 0, 1); PG8_STAGE(PG8_SB(0, 0), b2, Rb2, ldB2);
            PG8_BAR; PG8_WAIT_L(0); PG8_MMA(0, 1, At, B1); PG8_BAR;
            PG8_LDA(At, 0, 1); PG8_STAGE(PG8_SA(0, 0), a2, R2, ldA2);
            PG8_BAR; PG8_WAIT_L(0); PG8_MMA(1, 0, At, B0); PG8_BAR; PG8_SCHED;
            PG8_STAGE(PG8_SB(0, 1), b2 + hB2, Rb2, ldB2);
            PG8_WAIT_V(6); PG8_BAR; PG8_MMA(1, 1, At, B1); PG8_BAR;
            PG8_LDB(B0, 1, 0); PG8_SCHED; PG8_LDA(At, 1, 0); PG8_STAGE(PG8_SA(0, 1), a2 + hA2, R2, ldA2);
            PG8_WAIT_L(8); PG8_BAR; PG8_WAIT_L(0); PG8_MMA(0, 0, At, B0); PG8_BAR; PG8_SCHED;
            PG8_LDB(B1, 1, 1); PG8_STAGE(PG8_SB(1, 0), b3, Rb2, ldB2);
            PG8_BAR; PG8_WAIT_L(0); PG8_MMA(0, 1, At, B1); PG8_BAR;
            PG8_LDA(At, 1, 1); PG8_STAGE(PG8_SA(1, 0), a3, R2, ldA2);
            PG8_BAR; PG8_WAIT_L(0); PG8_MMA(1, 0, At, B0); PG8_BAR; PG8_SCHED;
            PG8_STAGE(PG8_SB(1, 1), b3 + hB2, Rb2, ldB2);
            PG8_WAIT_V(6); PG8_BAR; PG8_MMA(1, 1, At, B1); PG8_BAR;
        }
        E(acc, cur, st, wr, wc, fr, fq);
        if (!has_next) break;
#pragma unroll
        for (int a = 0; a < 2; ++a)
#pragma unroll
            for (int b = 0; b < 2; ++b)
#pragma unroll
                for (int m = 0; m < 4; ++m)
#pragma unroll
                    for (int n = 0; n < 2; ++n) acc[a][b][m][n] = (f32x4){0.f, 0.f, 0.f, 0.f};
        cur = nxt; cA = nA; cB = nB; if (sn == 0) ++ti; st = sn;
    }
    PG8_WAIT_V(0);
    if (wr == 0) PG8_BAR;
    PG8_BAR;
#undef PG8_SA
#undef PG8_SB
#undef PG8_STAGE
#undef PG8_LDA
#undef PG8_LDB
#undef PG8_MMA
#undef PG8_WAIT_V
#undef PG8_WAIT_L
#undef PG8_BAR
#undef PG8_SCHED
}
template <class Epi, class Sched>
DEVI void gemm_phase_gather(char* lds_generic, const Gemm g, const Sched& S, const Epi& E) {
    PG8_LAS unsigned char* lds = (PG8_LAS unsigned char*)lds_generic;
    const int tid = tidx(), wid = __builtin_amdgcn_readfirstlane(tid >> 6), lane = tid & 63, wr = wid >> 2, wc = wid & 3, fr = lane & 15, fq = lane >> 4;
    const int K = g.K, nt = K / BK;
    unsigned voffB[2];
#pragma unroll
    for (int i = 0; i < 2; ++i) { int R, C; stage_rc(tid * 16 + i * 8192, R, C); const int Rb = Epi::PERM ? ((R & ~31) + perm32(R & 31)) : R;
        voffB[i] = (unsigned)(Rb * K + C) * 2u; }
    unsigned pa[2][2], pn[2][2];
#define PG8_ROWS(P, u) do { int kk_, sb_, nn_; S.unit_rows(u, kk_, sb_, nn_); const int t16_ = tidx() * 16; _Pragma("unroll") for (int i_ = 0; i_ < 2; ++i_) { int R_, C_; stage_rc(t16_ + i_ * 8192, R_, C_); \
        _Pragma("unroll") for (int h_ = 0; h_ < 2; ++h_) P[h_][i_] = S.row_off(kk_, sb_ + h_ * HALF + R_, nn_) + (unsigned)(C_ * 2); } } while (0)
#define PG8_STAGE_AG(bufoff, P, h, koff) do { _Pragma("unroll") for (int _i = 0; _i < 2; ++_i) \
        __builtin_amdgcn_global_load_lds((const unsigned*)((const char*)g.A + (size_t)P[h][_i] + (koff)), (PG8_LAS unsigned*)(lds + (bufoff) + ldsw + _i * 8192), 16, 0, 0); } while (0)
    const size_t kstep = (size_t)(BK * 2);
    const size_t hstep = (size_t)HALF * K * 2;
    const size_t tstep = 2 * hstep;
    const unsigned ldsw = (unsigned)wid * 1024u;
    const int aoff = lds_byte(wr * 64 + fr, fq * 8), boff = lds_byte(wc * 32 + fr, fq * 8);
#define PG8_SA(b, h) (((b) * 2 + (h)) * HTB)
#define PG8_SB(b, h) ((4 + (b) * 2 + (h)) * HTB)
#define PG8_STAGE(bufoff, gbase, voff) do { _Pragma("unroll") for (int _i = 0; _i < 2; ++_i) \
        __builtin_amdgcn_global_load_lds((const unsigned*)((const char*)(gbase) + (voff)[_i]), (PG8_LAS unsigned*)(lds + (bufoff) + ldsw + _i * 8192), 16, 0, 0); } while (0)
#define PG8_LDA(dst, b, h) do { _Pragma("unroll") for (int m = 0; m < 4; ++m) _Pragma("unroll") for (int k = 0; k < 2; ++k) dst[m][k] = *(const PG8_LAS bf16x8*)(lds + PG8_SA(b, h) + aoff + m * 2048 + k * 1024); } while (0)
#define PG8_LDB(dst, b, h) do { _Pragma("unroll") for (int n = 0; n < 2; ++n) _Pragma("unroll") for (int k = 0; k < 2; ++k) dst[n][k] = *(const PG8_LAS bf16x8*)(lds + PG8_SB(b, h) + boff + n * 2048 + k * 1024); } while (0)
#define PG8_MMA(ai, bj, At, Bt) do { __builtin_amdgcn_s_setprio(1); _Pragma("unroll") for (int m = 0; m < 4; ++m) _Pragma("unroll") for (int n = 0; n < 2; ++n) _Pragma("unroll") for (int k = 0; k < 2; ++k) \
        acc[ai][bj][m][n] = __builtin_amdgcn_mfma_f32_16x16x32_bf16(Bt[n][k], At[m][k], acc[ai][bj][m][n], 0, 0, 0); __builtin_amdgcn_s_setprio(0); } while (0)
#define PG8_WAIT_V(n) asm volatile("s_waitcnt vmcnt(" #n ")" ::: "memory")
#define PG8_WAIT_L(n) asm volatile("s_waitcnt lgkmcnt(" #n ")" ::: "memory")
#define PG8_BAR __builtin_amdgcn_s_barrier()
#define PG8_SCHED __builtin_amdgcn_sched_barrier(0)
    __syncthreads();
    Unit cur, nxt; int ui = 0;
    if (!S.next(0, cur)) return;
    f32x4 acc[2][2][4][2];
#pragma unroll
    for (int a = 0; a < 2; ++a)
#pragma unroll
        for (int b = 0; b < 2; ++b)
#pragma unroll
            for (int m = 0; m < 4; ++m)
#pragma unroll
                for (int n = 0; n < 2; ++n) acc[a][b][m][n] = (f32x4){0.f, 0.f, 0.f, 0.f};
    bf16x8 At[4][2], B0[2][2], B1[2][2];
    const char* cB = (const char*)g.Bt + (size_t)cur.pn * tstep;
    PG8_ROWS(pa, cur);
    PG8_STAGE(PG8_SB(0, 0), cB, voffB); PG8_STAGE_AG(PG8_SA(0, 0), pa, 0, 0); PG8_STAGE(PG8_SB(0, 1), cB + hstep, voffB); PG8_STAGE_AG(PG8_SA(0, 1), pa, 1, 0);
    if (wr == 1) PG8_BAR;
    PG8_WAIT_V(4); PG8_BAR;
    PG8_STAGE(PG8_SB(1, 0), cB + kstep, voffB); PG8_STAGE_AG(PG8_SA(1, 0), pa, 0, kstep); PG8_STAGE(PG8_SB(1, 1), cB + hstep + kstep, voffB);
    PG8_WAIT_V(6); PG8_BAR;
    for (;;) {
        const bool has_next = S.next(ui + 1, nxt);
        const char* nB = has_next ? (const char*)g.Bt + (size_t)nxt.pn * tstep : cB;
        if (has_next) PG8_ROWS(pn, nxt);
        else { _Pragma("unroll") for (int h_ = 0; h_ < 2; ++h_) _Pragma("unroll") for (int i_ = 0; i_ < 2; ++i_) pn[h_][i_] = pa[h_][i_]; }
        for (int t = 0; t < nt; t += 2) {
            const bool last = (t == nt - 2);
            const size_t k1 = (size_t)(t + 1) * kstep, k2 = (size_t)(t + 2) * kstep, k3 = (size_t)(t + 3) * kstep;
            const char* b2 = last ? nB : cB + k2;
            const char* b3 = b2 + kstep;
            PG8_LDB(B0, 0, 0); PG8_SCHED; PG8_LDA(At, 0, 0); PG8_STAGE_AG(PG8_SA(1, 1), pa, 1, k1);
            PG8_WAIT_L(8); PG8_BAR; PG8_WAIT_L(0); PG8_MMA(0, 0, At, B0); PG8_BAR; PG8_SCHED;
            PG8_LDB(B1, 0, 1); PG8_STAGE(PG8_SB(0, 0), b2, voffB);
            PG8_BAR; PG8_WAIT_L(0); PG8_MMA(0, 1, At, B1); PG8_BAR;
            PG8_LDA(At, 0, 1); if (last) PG8_STAGE_AG(PG8_SA(0, 0), pn, 0, 0); else PG8_STAGE_AG(PG8_SA(0, 0), pa, 0, k2);
            PG8_BAR; PG8_WAIT_L(0); PG8_MMA(1, 0, At, B0); PG8_BAR; PG8_SCHED;
            PG8_STAGE(PG8_SB(0, 1), b2 + hstep, voffB);
            PG8_WAIT_V(6); PG8_BAR; PG8_MMA(1, 1, At, B1); PG8_BAR;
            PG8_LDB(B0, 1, 0); PG8_SCHED; PG8_LDA(At, 1, 0); if (last) PG8_STAGE_AG(PG8_SA(0, 1), pn, 1, 0); else PG8_STAGE_AG(PG8_SA(0, 1), pa, 1, k2);
            PG8_WAIT_L(8); PG8_BAR; PG8_WAIT_L(0); PG8_MMA(0, 0, At, B0); PG8_BAR; PG8_SCHED;
            PG8_LDB(B1, 1, 1); PG8_STAGE(PG8_SB(1, 0), b3, voffB);
            PG8_BAR; PG8_WAIT_L(0); PG8_MMA(0, 1, At, B1); PG8_BAR;
            PG8_LDA(At, 1, 1); if (last) PG8_STAGE_AG(PG8_SA(1, 0), pn, 0, kstep); else PG8_STAGE_AG(PG8_SA(1, 0), pa, 0, k3);
            PG8_BAR; PG8_WAIT_L(0); PG8_MMA(1, 0, At, B0); PG8_BAR; PG8_SCHED;
            PG8_STAGE(PG8_SB(1, 1), b3 + hstep, voffB);
            PG8_WAIT_V(6); PG8_BAR; PG8_MMA(1, 1, At, B1); PG8_BAR;
        }
        E(acc, cur, wr, wc, fr, fq); S.done(cur);
        if (!has_next) break;
#pragma unroll
        for (int a = 0; a < 2; ++a)
#pragma unroll
            for (int b = 0; b < 2; ++b)
#pragma unroll
                for (int m = 0; m < 4; ++m)
#pragma unroll
                    for (int n = 0; n < 2; ++n) acc[a][b][m][n] = (f32x4){0.f, 0.f, 0.f, 0.f};
        cur = nxt; cB = nB; ++ui;
        _Pragma("unroll") for (int h_ = 0; h_ < 2; ++h_) _Pragma("unroll") for (int i_ = 0; i_ < 2; ++i_) pa[h_][i_] = pn[h_][i_];
    }
    PG8_WAIT_V(0);
    if (wr == 0) PG8_BAR;
    PG8_BAR;
#undef PG8_SA
#undef PG8_ROWS
#undef PG8_STAGE_AG
#undef PG8_SB
#undef PG8_STAGE
#undef PG8_LDA
#undef PG8_LDB
#undef PG8_MMA
#undef PG8_WAIT_V
#undef PG8_WAIT_L
#undef PG8_BAR
#undef PG8_SCHED
}
struct EpiStoreBf16 {
    static constexpr bool PERM = true;
    bf16_t* O; int ld;
    DEVI void operator()(const f32x4 (&acc)[2][2][4][2], const Unit& u, int wr, int wc, int fr, int fq) const {
        const int row0 = u.pm * BM + wr * 64 + fr, col0 = u.pn * BM + wc * 32 + 8 * fq;
#pragma unroll
        for (int ai = 0; ai < 2; ++ai)
#pragma unroll
            for (int m = 0; m < 4; ++m) { bf16_t* rowp = O + (size_t)(row0 + ai * HALF + m * 16) * ld + col0;
#pragma unroll
                for (int bj = 0; bj < 2; ++bj) { const u32x4 w = {pk2(acc[ai][bj][m][0][0], acc[ai][bj][m][0][1]), pk2(acc[ai][bj][m][0][2], acc[ai][bj][m][0][3]),
                                                                 pk2(acc[ai][bj][m][1][0], acc[ai][bj][m][1][1]), pk2(acc[ai][bj][m][1][2], acc[ai][bj][m][1][3])};
                    *(u32x4*)(rowp + bj * HALF) = w; } }
    }
};
template <bool F32IN> struct EpiResid {
    static constexpr bool PERM = true;
    const float* xf; bf16_t* xb; float* part;
    mutable float ssqa[2][4];
    DEVI void operator()(const f32x4 (&acc)[2][2][4][2], const Unit& u, int wr, int wc, int fr, int fq) const {
        const int row0 = u.pm * BM + wr * 64 + fr, col0 = u.pn * BM + wc * 32 + 8 * fq, lane = fr | (fq << 4);
#pragma unroll
        for (int ai = 0; ai < 2; ++ai) {
            float xin[4][2][8];
#pragma unroll
            for (int m = 0; m < 4; ++m)
#pragma unroll
                for (int bj = 0; bj < 2; ++bj) {
                    const int row = row0 + ai * HALF + m * 16, col = col0 + bj * HALF;
                    if (F32IN) { const f32x4 a = *(const f32x4*)(xf + (size_t)row * DM + col), b = *(const f32x4*)(xf + (size_t)row * DM + col + 4);
#pragma unroll
                        for (int e = 0; e < 4; ++e) { xin[m][bj][e] = a[e]; xin[m][bj][4 + e] = b[e]; } }
                    else unpack8(*(const bf16x8*)(xb + (size_t)row * XLD + col), xin[m][bj]);
                }
#pragma unroll
            for (int m = 0; m < 4; ++m) {
                const int row = row0 + ai * HALF + m * 16;
                float ssq = 0.f;
#pragma unroll
                for (int bj = 0; bj < 2; ++bj) {
                    const int col = col0 + bj * HALF;
                    float o[8];
#pragma unroll
                    for (int e = 0; e < 4; ++e) { o[e] = xin[m][bj][e] + acc[ai][bj][m][0][e]; o[4 + e] = xin[m][bj][4 + e] + acc[ai][bj][m][1][e]; }
#pragma unroll
                    for (int e = 0; e < 8; ++e) ssq += o[e] * o[e];
                    *(bf16x8*)(xb + (size_t)row * XLD + col) = pack8(o);
                }
                ssq += ssqa[ai][m];
                if (u.pn == 3) {
                    ssq += __int_as_float(__builtin_amdgcn_ds_bpermute((lane ^ 16) << 2, __float_as_int(ssq)));
                    ssq += __int_as_float(__builtin_amdgcn_ds_bpermute((lane ^ 32) << 2, __float_as_int(ssq)));
                    if (fq == 0) part[(size_t)row * 4 + wc] = ssq;
                    ssq = 0.f;
                }
                ssqa[ai][m] = ssq;
            }
        }
    }
};
struct EpiStoreScaled {
    static constexpr bool PERM = true;
    bf16_t* O; int ld; const float* rss;
    DEVI void operator()(const f32x4 (&acc)[2][2][4][2], const Unit& u, int wr, int wc, int fr, int fq) const {
        const int row0 = u.pm * BM + wr * 64 + fr, col0 = u.pn * BM + wc * 32 + 8 * fq;
#pragma unroll
        for (int ai = 0; ai < 2; ++ai)
#pragma unroll
            for (int m = 0; m < 4; ++m) { const int row = row0 + ai * HALF + m * 16;
                const f32x4 pv = *(const f32x4*)(rss + (size_t)row * 4); const float r = rsqrtf((pv[0] + pv[1] + pv[2] + pv[3]) * (1.f / DM) + EPS);
                bf16_t* rowp = O + (size_t)row * ld + col0;
#pragma unroll
                for (int bj = 0; bj < 2; ++bj) { const f32x4 a = acc[ai][bj][m][0] * r, b = acc[ai][bj][m][1] * r;
                    const u32x4 w = {pk2(a[0], a[1]), pk2(a[2], a[3]), pk2(b[0], b[1]), pk2(b[2], b[3])};
                    *(u32x4*)(rowp + bj * HALF) = w; } }
    }
};
}

DEVI void rmsnorm_to_bf16(const float* src, const float* gain, bf16_t* dst, int nrows) {
    const int lane = tidx() & 63, wid = tidx() >> 6;
    const f32x4* g4 = (const f32x4*)gain;
    f32x4 g[4];
#pragma unroll
    for (int j = 0; j < 4; ++j) g[j] = g4[lane + 64 * j];
    for (int row0 = (bidx() * 8 + wid) * 2; row0 < nrows; row0 += gdim() * 16) {
        f32x4 v[2][4];
#pragma unroll
        for (int rr = 0; rr < 2; ++rr) { const f32x4* s = (const f32x4*)(src + (size_t)(row0 + rr) * DM);
#pragma unroll
            for (int j = 0; j < 4; ++j) v[rr][j] = s[lane + 64 * j]; }
#pragma unroll
        for (int rr = 0; rr < 2; ++rr) {
            float ss = 0.f;
#pragma unroll
            for (int j = 0; j < 4; ++j) ss += v[rr][j][0] * v[rr][j][0] + v[rr][j][1] * v[rr][j][1] + v[rr][j][2] * v[rr][j][2] + v[rr][j][3] * v[rr][j][3];
            ss = wave_sum(ss);
            const float r = rsqrtf(ss * (1.f / DM) + EPS);
#pragma unroll
            for (int j = 0; j < 4; ++j) *(u32x2*)(dst + (size_t)(row0 + rr) * DM + (lane + 64 * j) * 4) = pack4(v[rr][j] * r * g[j]);
        }
    }
}

template <class SF>
DEVI void convT(bf16_t* dst, int N, int K, SF sf, char* lds) {
    bf16_t* tile = (bf16_t*)lds;
    const int tid = tidx();
    const int ntk = K >> 6, ntiles = (N >> 7) * ntk;
    const int nn = tid & 63, kk0 = tid >> 6, on = tid >> 3, kc = (tid & 7) * 8;
    float va[16], vb[16];
#define CT_LOAD(V, t_) do { const int n0_ = ((t_) / ntk) << 7, k0_ = ((t_) % ntk) << 6; _Pragma("unroll") for (int h = 0; h < 2; ++h) _Pragma("unroll") for (int i = 0; i < 8; ++i) V[h * 8 + i] = sf(k0_ + kk0 + 8 * i, n0_ + 64 * h + nn); } while (0)
#define CT_EMIT(V, t_) do { const int n0_ = ((t_) / ntk) << 7, k0_ = ((t_) % ntk) << 6;                                  \
        __syncthreads();                                                                                                 \
        _Pragma("unroll") for (int h = 0; h < 2; ++h) _Pragma("unroll") for (int i = 0; i < 8; ++i) tile[h * (64 * 66) + (kk0 + 8 * i) * 66 + nn] = f2bf(V[h * 8 + i]); \
        __syncthreads();                                                                                                 \
        _Pragma("unroll") for (int h = 0; h < 2; ++h) { u32x4 w;                                                         \
        _Pragma("unroll") for (int e = 0; e < 4; ++e) w[e] = (unsigned)tile[h * (64 * 66) + (kc + 2 * e) * 66 + on] | ((unsigned)tile[h * (64 * 66) + (kc + 2 * e + 1) * 66 + on] << 16); \
        *(u32x4*)(dst + (size_t)(n0_ + 64 * h + on) * K + k0_ + kc) = w; } } while (0)
    const int G_ = gdim();
    int t = bidx();
    if (t < ntiles) CT_LOAD(va, t);
    for (; t < ntiles; t += 2 * G_) {
        if (t + G_ < ntiles) CT_LOAD(vb, t + G_);
        CT_EMIT(va, t);
        if (t + G_ < ntiles) {
            if (t + 2 * G_ < ntiles) CT_LOAD(va, t + 2 * G_);
            CT_EMIT(vb, t + G_);
        }
    }
#undef CT_LOAD
#undef CT_EMIT
}

DEVI void phase_prologue(const Params& p, int, char*) {
    const int gt = bidx() * NTHR + tidx(), gn = gdim() * NTHR;
    if (gt < 128) WSP(unsigned, OFF_CNT)[gt] = 0u;
    if (gt < 32) WSB(OFF_ONES)[gt] = gt == 0 ? (bf16_t)0x3F80 : (bf16_t)0;
    const int* pos = G((const int*)p.in[I_POS]);
    float* rc = WSF(OFF_ROPE_C); float* rs = WSF(OFF_ROPE_S);
    for (int i = gt; i < T_ * 16; i += gn) {
        const int t = i >> 4, j = i & 15;
        const float inv = 1.0f / powf(10000.0f, (float)(2 * j) / 32.0f);
        const float ang = (float)pos[t] * inv;
        rc[i] = cosf(ang); rs[i] = sinf(ang);
    }
    rmsnorm_to_bf16(INF(I_MEM), INF(I_MEMNORM), WSB(OFF_MEMN), NBATCH * 256);
}

DEVI void phase_weights(const Params& p, int l, char* lds) {
    const float* w_in = INF(I_WIN) + (size_t)l * DM * NIN;
    convT(WW(W_P), 4352, 1024, [&](int k, int n) { const int c = n < 2592 ? n : (n < 2816 ? -1 : n - 224); return c < 0 ? 0.f : w_in[(size_t)k * NIN + c]; }, lds);
    convT(WW(W_G), 4096, 1024, [&](int k, int n) { return w_in[(size_t)k * NIN + 4128 + n]; }, lds);
    { const float* s = INF(I_WOUTA) + (size_t)l * 512 * 1024; convT(WW(W_OA), 1024, 512, [&](int k, int n) { return s[(size_t)k * 1024 + n]; }, lds); }
    { const float* s = INF(I_S5GLU) + (size_t)l * 512 * 2048;
      convT(WW(W_GLU), 2048, 512, [&](int k, int n) { const int c = ((n >> 2) & 1) * 1024 + (n >> 8) * 128 + ((n >> 5) & 3) * 32 + ((n >> 3) & 3) * 8 + ((n >> 7) & 1) * 4 + (n & 3);
                                                      return s[(size_t)k * 2048 + c]; }, lds); }
    { const float* s = INF(I_WQB) + (size_t)l * 256 * 768; convT(WW(W_QB), 768, 256, [&](int k, int n) { return s[(size_t)k * 768 + n] * MLA_C; }, lds); }
    { const float* s = INF(I_WKVB) + (size_t)l * 256 * 1024; convT(WW(W_KVB), 1024, 256, [&](int k, int n) { return s[(size_t)k * 1024 + n]; }, lds); }
    { const float* s = INF(I_MLAWO) + (size_t)l * 512 * 1024; convT(WW(W_MO), 1024, 512, [&](int k, int n) { return s[(size_t)k * 1024 + n]; }, lds); }
    { const float* s = INF(I_HYWOUT) + (size_t)l * 512 * 1024; convT(WW(W_HO), 1024, 512, [&](int k, int n) { return s[(size_t)k * 1024 + n]; }, lds); }
    { const float* s = INF(I_WMIX) + (size_t)l * 1024 * 1024; convT(WW(W_MIX), 1024, 1024, [&](int k, int n) { return s[(size_t)k * 1024 + n]; }, lds); }
    { const float* s = INF(I_XAWQ) + (size_t)l * 1024 * 512; const float* gx = INF(I_XANORM) + l * DM; convT(WW(W_XQ), 512, 1024, [&](int k, int n) { return s[(size_t)k * 512 + n] * gx[k]; }, lds); }
    { const float* s = INF(I_XAWKV) + (size_t)l * 1024 * 1024; convT(WW(W_XKV), 1024, 1024, [&](int k, int n) { return s[(size_t)k * 1024 + n]; }, lds); }
    { const float* s = INF(I_XAWO) + (size_t)l * 512 * 1024; convT(WW(W_XO), 1024, 512, [&](int k, int n) { return s[(size_t)k * 1024 + n]; }, lds); }
    { const float* sg = INF(I_MOEWG) + (size_t)l * 1024 * 4; const float* se = INF(I_MOEWE) + (size_t)l * 1024 * 32;
      const float* gm = INF(I_MOENORM) + l * DM;
      convT(WW(W_RT), 256, 1024, [&](int k, int n) { return (n < 4 ? sg[k * 4 + n] : (n < 36 ? se[k * 32 + (n - 4)] : 0.f)) * gm[k]; }, lds); }
    { const float* sg = INF(I_MOEGATE) + (size_t)l * 32 * 1024 * 256; const float* su = INF(I_MOEUP) + (size_t)l * 32 * 1024 * 256;
      convT(WW(W_GU), 32 * 512, 1024, [&](int k, int nn) { const int e = nn >> 9, n = nn & 511; const int col = (n >> 5) * 16 + (n & 15);
          const float* s = ((n >> 4) & 1) ? su : sg; return s[((size_t)e * 1024 + k) * 256 + col] * INF(I_MOENORM)[l * DM + k]; }, lds); }
    { const float* sd = INF(I_MOEDOWN) + (size_t)l * 32 * 256 * 1024;
      convT(WW(W_D), 32 * 1024, 256, [&](int k, int nn) { const int e = nn >> 10, n = nn & 1023; return sd[((size_t)e * 256 + k) * 1024 + n]; }, lds); }
    {
        float* zs = (float*)lds;
        float* h1s = (float*)lds + 8 * 36;
        const float* w1 = INF(I_HYW1) + l * 33 * 64; const float* b1 = INF(I_HYB1) + l * 64;
        const float* w2 = INF(I_HYW2) + l * 64 * 64; const float* b2 = INF(I_HYB2) + l * 64;
        const float* fr = INF(I_HYFREQ) + l * 64;
        float* h2 = WSF(OFF_H2);
        const int tl = tidx() >> 6, j = tidx() & 63;
        float w1r[33], w2r[64];
#pragma unroll
        for (int i = 0; i < 33; ++i) w1r[i] = w1[i * 64 + j];
#pragma unroll
        for (int i = 0; i < 64; ++i) w2r[i] = w2[i * 64 + j];
        const float b1j = b1[j], b2j = b2[j], frj = fr[j];
        for (int u = bidx(); u < SEQ / 8; u += gdim()) {
            const int t = u * 8 + tl;
            __syncthreads();
            if (j < 33) {
                float z;
                if (j == 0) z = (float)t / (float)(SEQ - 1);
                else {
                    const int bi = (j - 1) & 15;
                    const float band = 1e-4f + (float)bi * ((15.0f - 1e-4f) / 15.0f);
                    const float ang = (6.283185307179586f / (float)SEQ) * (float)t * band;
                    z = (j <= 16) ? cosf(ang) : -sinf(ang);
                }
                zs[tl * 36 + j] = z;
            }
            __syncthreads();
            float a = b1j;
#pragma unroll
            for (int i = 0; i < 33; ++i) a += zs[tl * 36 + i] * w1r[i];
            h1s[tl * 64 + j] = sinf(frj * a);
            __syncthreads();
            float c = b2j;
#pragma unroll
            for (int i = 0; i < 64; ++i) c += h1s[tl * 64 + i] * w2r[i];
            h2[t * 64 + j] = sinf(frj * c);
        }
    }
}

template <bool FINAL>
DEVI void moe_combine_norm(const Params& p, const float* gain, bf16_t* dst) {
    const int lane = tidx() & 63, wid = tidx() >> 6;
    const f32x4* g4 = (const f32x4*)gain;
    const bf16_t* YD = WSB(OFF_YD); const int* RI = WSP(const int, OFF_ROWIDX);
    bf16_t* xb = XB; float* outp = OUTP;
    for (int row = bidx() * 8 + wid; row < T_; row += gdim() * 8) {
        const u32x2* xs = (const u32x2*)(xb + (size_t)row * XLD);
        const u32x2* y0 = (const u32x2*)(YD + (size_t)RI[row] * DM); const u32x2* y1 = (const u32x2*)(YD + (size_t)RI[T_ + row] * DM);
        f32x4 v[4]; float ss = 0.f;
#pragma unroll
        for (int j = 0; j < 4; ++j) {
            const u32x2 x = xs[lane + 64 * j], a = y0[lane + 64 * j], b = y1[lane + 64 * j];
            v[j] = (f32x4){bflo(x[0]) + bflo(a[0]) + bflo(b[0]), bfhi(x[0]) + bfhi(a[0]) + bfhi(b[0]), bflo(x[1]) + bflo(a[1]) + bflo(b[1]), bfhi(x[1]) + bfhi(a[1]) + bfhi(b[1])};
            ss += v[j][0] * v[j][0] + v[j][1] * v[j][1] + v[j][2] * v[j][2] + v[j][3] * v[j][3];
        }
        ss = wave_sum(ss);
        const float r = rsqrtf(ss * (1.f / DM) + EPS);
#pragma unroll
        for (int j = 0; j < 4; ++j) {
            const f32x4 o = v[j] * r * g4[lane + 64 * j];
            if (FINAL) ((f32x4*)(outp + (size_t)row * DM))[lane + 64 * j] = o;
            else { *(u32x2*)(xb + (size_t)row * XLD + (lane + 64 * j) * 4) = pack4(v[j]); *(u32x2*)(dst + (size_t)row * DM + (lane + 64 * j) * 4) = pack4(o); }
        }
    }
}

DEVI void phase_hy_filter(const Params& p, int l, char* lds) {
    const int tid = tidx(), lane = tid & 63, wid = tid >> 6;
    float* w3s = (float*)lds;
    float* red = (float*)lds + 512;
    const float* w3 = INF(I_HYW3) + (size_t)l * 64 * 2048;
    const float* h2 = WSF(OFF_H2);
    bf16_t* R = WSB(OFF_RTAB);
    const float mind = logf(0.01f) / 1.5f, maxd = logf(0.01f) / 0.3f;
    for (int ug = bidx(); ug < 256; ug += gdim()) {
        const int u0 = ug * 4, o = u0 >> 9, c0 = u0 & 511;
        __syncthreads();
        { const int j = tid >> 7, d = (tid >> 6) & 1, i = tid & 63; w3s[tid] = w3[i * 2048 + o * 1024 + d * 512 + c0 + j]; }
        __syncthreads();
        float delta[4];
#pragma unroll
        for (int j = 0; j < 4; ++j) delta[j] = fabsf(mind + (float)(c0 + j) * ((maxd - mind) / 511.0f));
        float fw[4][8], bw[4][8], ss[4] = {0.f, 0.f, 0.f, 0.f};
#pragma unroll
        for (int r = 0; r < 8; ++r) {
            const int t = tid + 512 * r;
            const f32x4* hr = (const f32x4*)(h2 + t * 64);
            float a[4][2];
#pragma unroll
            for (int j = 0; j < 4; ++j) { a[j][0] = 0.f; a[j][1] = 0.f; }
#pragma unroll 2
            for (int q = 0; q < 16; ++q) {
                const f32x4 hv = hr[q];
#pragma unroll
                for (int j = 0; j < 4; ++j)
#pragma unroll
                    for (int d = 0; d < 2; ++d) { const f32x4 wv = *(const f32x4*)(w3s + (j * 2 + d) * 64 + 4 * q);
                        a[j][d] += hv[0] * wv[0] + hv[1] * wv[1] + hv[2] * wv[2] + hv[3] * wv[3]; }
            }
            const float tn = (float)t / (float)(SEQ - 1);
#pragma unroll
            for (int j = 0; j < 4; ++j) {
                const float dec = expf(-tn * delta[j]);
                const float x = a[j][0] * dec, y = a[j][1] * dec; fw[j][r] = x; bw[j][r] = y;
                ss[j] += x * x + (t >= 1 ? y * y : 0.f);
            }
        }
#pragma unroll
        for (int j = 0; j < 4; ++j) { ss[j] = wave_sum(ss[j]); if (lane == 0) red[wid * 4 + j] = ss[j]; }
        __syncthreads();
#pragma unroll
        for (int j = 0; j < 4; ++j) {
            float tot = 0.f;
#pragma unroll
            for (int w = 0; w < 8; ++w) tot += red[w * 4 + j];
            const float sc = rsqrtf(tot + EPS);
            bf16_t* Ru = R + (size_t)(u0 + j) * 8192;
#pragma unroll
            for (int r = 0; r < 8; ++r) {
                const int t = tid + 512 * r;
                Ru[4096 - t] = f2bf(fw[j][r] * sc);
                if (t >= 1) Ru[4096 + t] = f2bf(bw[j][r] * sc);
            }
            if (tid == 0) Ru[0] = 0;
        }
    }
}
DEVI void phase_norm_mix(const Params& p, int l, char* lds) {
    if (l == 0) rmsnorm_to_bf16(INF(I_X), INF(I_MIXNORM), WSB(OFF_H), T_);
    else moe_combine_norm<false>(p, INF(I_MIXNORM) + l * DM, WSB(OFF_H));
}
DEVI void rmsnorm_xb(const bf16_t* xb, const float* gain, bf16_t* dst) {
    const int lane = tidx() & 63, wid = tidx() >> 6;
    f32x4 g[4];
#pragma unroll
    for (int j = 0; j < 4; ++j) g[j] = ((const f32x4*)gain)[lane + 64 * j];
    for (int row0 = (bidx() * 8 + wid) * 4; row0 < T_; row0 += gdim() * 32) {
        u32x2 v[4][4];
#pragma unroll
        for (int rr = 0; rr < 4; ++rr)
#pragma unroll
            for (int j = 0; j < 4; ++j) v[rr][j] = *(const u32x2*)(xb + (size_t)(row0 + rr) * XLD + (lane + 64 * j) * 4);
#pragma unroll
        for (int rr = 0; rr < 4; ++rr) {
            f32x4 x[4]; float ss = 0.f;
#pragma unroll
            for (int j = 0; j < 4; ++j) { x[j] = (f32x4){bflo(v[rr][j][0]), bfhi(v[rr][j][0]), bflo(v[rr][j][1]), bfhi(v[rr][j][1])};
                ss += x[j][0] * x[j][0] + x[j][1] * x[j][1] + x[j][2] * x[j][2] + x[j][3] * x[j][3]; }
            ss = wave_sum(ss);
            const float r = rsqrtf(ss * (1.f / DM) + EPS);
#pragma unroll
            for (int j = 0; j < 4; ++j) *(u32x2*)(dst + (size_t)(row0 + rr) * DM + (lane + 64 * j) * 4) = pack4(x[j] * r * g[j]);
        }
    }
}
DEVI void phase_norm_xa(const Params& p, int l, char*) { rmsnorm_xb(XB, INF(I_XANORM) + l * DM, WSB(OFF_H)); }
DEVI void phase_norm_moe(const Params& p, int l, char*) { rmsnorm_xb(XB, INF(I_MOENORM) + l * DM, WSB(OFF_H)); }

struct EpiP {
    static constexpr bool PERM = true;
    bf16_t *pa, *ps, *pm, *ph;
    template <int LD>
    DEVI void store(bf16_t* dst, int cb, const f32x4 (&acc)[2][2][4][2], int pm_, int wr, int wc, int fr, int fq) const {
        bf16_t* base = dst + (size_t)(pm_ * 256 + wr * 64 + fr) * LD + cb + wc * 32 + 8 * fq;
#pragma unroll
        for (int ai = 0; ai < 2; ++ai)
#pragma unroll
            for (int m = 0; m < 4; ++m)
#pragma unroll
                for (int bj = 0; bj < 2; ++bj) {
                    const u32x4 w = {pk2(acc[ai][bj][m][0][0], acc[ai][bj][m][0][1]), pk2(acc[ai][bj][m][0][2], acc[ai][bj][m][0][3]),
                                     pk2(acc[ai][bj][m][1][0], acc[ai][bj][m][1][1]), pk2(acc[ai][bj][m][1][2], acc[ai][bj][m][1][3])};
                    *(u32x4*)(base + (ai * 128 + m * 16) * LD + bj * 128) = w; }
    }
    DEVI void operator()(const f32x4 (&acc)[2][2][4][2], const pg8::Unit& u, int wr, int wc, int fr, int fq) const {
        if (u.pn < 6) store<1536>(pa, u.pn * 256, acc, u.pm, wr, wc, fr, fq);
        else if (u.pn < 8) store<512>(ps, (u.pn - 6) * 256, acc, u.pm, wr, wc, fr, fq);
        else if (u.pn < 11) store<768>(pm, (u.pn - 8) * 256, acc, u.pm, wr, wc, fr, fq);
        else store<1536>(ph, (u.pn - 11) * 256, acc, u.pm, wr, wc, fr, fq);
    }
};
DEVI void phase_pgemm(const Params& p, int l, char* lds) {
    {
        pg8::StaticOrder S; S.init(T_, 4352, gdim(), bidx());
        pg8::gemm_phase(lds, pg8::Gemm{WSB(OFF_H), WW(W_P), T_, 4352, DM}, S, EpiP{WSB(OFF_PA), WSB(OFF_PS), WSB(OFF_PM), WSB(OFF_PH)});
    }
}
DEVI void phase_mixA(const Params& p, int l, char* lds) {
    phase_hy_filter(p, l, lds);
    const bf16_t* PA = WSB(OFF_PA); bf16_t* ZA = WSB(OFF_ZA);
    const float* cw = INF(I_CONVA) + l * 3 * 512;
    const int gt = bidx() * NTHR + tidx(), j0 = (gt & 63) * 8;
    float w0[8], w1[8], w2[8];
#pragma unroll
    for (int e = 0; e < 8; ++e) { w0[e] = cw[j0 + e]; w1[e] = cw[512 + j0 + e]; w2[e] = cw[1024 + j0 + e]; }
    for (int i = gt; i < T_ * 64; i += gdim() * NTHR) {
        const int t = i >> 6, tt = t & (SEQ - 1);
        const bf16_t* row = PA + (size_t)t * 1536;
        const bf16x8 z8 = {0, 0, 0, 0, 0, 0, 0, 0};
        const bool hasp = tt > 0, hasn = tt < SEQ - 1;
        const bf16x8 cp = hasp ? *(const bf16x8*)(row - 1536 + 512 + j0) : z8, xp = hasp ? *(const bf16x8*)(row - 1536 + 1024 + j0) : z8;
        const bf16x8 cc_ = *(const bf16x8*)(row + 512 + j0), xc = *(const bf16x8*)(row + 1024 + j0);
        const bf16x8 cn = hasn ? *(const bf16x8*)(row + 1536 + 512 + j0) : z8, xn = hasn ? *(const bf16x8*)(row + 1536 + 1024 + j0) : z8;
        const bf16x8 bb = *(const bf16x8*)(row + j0);
        float a[8], b[8], c[8], d[8], e_[8], f[8], g_[8], o[8];
        unpack8(cp, a); unpack8(xp, b); unpack8(cc_, c); unpack8(xc, d); unpack8(cn, e_); unpack8(xn, f); unpack8(bb, g_);
#pragma unroll
        for (int e = 0; e < 8; ++e) o[e] = g_[e] * (w0[e] * a[e] * b[e] + w1[e] * c[e] * d[e] + w2[e] * e_[e] * f[e]);
        *(bf16x8*)(ZA + (size_t)t * 512 + j0) = pack8(o);
    }
}

DEVI void phase_mla_prep(const Params& p, int l, char*) {
    const int lane = tidx() & 63, wid = tidx() >> 6;
    const bf16_t* PM = WSB(OFF_PM);
    bf16_t* CQN = WSB(OFF_CQN); bf16_t* CKVN = WSB(OFF_CKVN); bf16_t* KR = WSB(OFF_KR);
    const f32x4 gq = ((const f32x4*)(INF(I_QNORM) + l * 256))[lane], gk = ((const f32x4*)(INF(I_KVNORM) + l * 256))[lane];
    const float* rc = WSF(OFF_ROPE_C); const float* rs = WSF(OFF_ROPE_S);
    for (int t0 = (bidx() * 8 + wid) * 4; t0 < T_; t0 += gdim() * 32) {
        u32x2 av[4], bv[4]; float x1[4], x2[4], cv[4], sv[4];
#pragma unroll
        for (int j = 0; j < 4; ++j) {
            const bf16_t* row = PM + (size_t)(t0 + j) * 768;
            av[j] = *(const u32x2*)(row + lane * 4); bv[j] = *(const u32x2*)(row + 256 + lane * 4);
            if (lane < 16) { x1[j] = bf2f(row[512 + lane]); x2[j] = bf2f(row[528 + lane]); cv[j] = rc[(size_t)(t0 + j) * 16 + lane]; sv[j] = rs[(size_t)(t0 + j) * 16 + lane]; }
        }
#pragma unroll
        for (int j = 0; j < 4; ++j) {
            const int t = t0 + j;
            const u32x2 a = av[j], b = bv[j];
            f32x4 q = {bflo(a[0]), bfhi(a[0]), bflo(a[1]), bfhi(a[1])}, k = {bflo(b[0]), bfhi(b[0]), bflo(b[1]), bfhi(b[1])};
            float sq = q[0] * q[0] + q[1] * q[1] + q[2] * q[2] + q[3] * q[3], sk = k[0] * k[0] + k[1] * k[1] + k[2] * k[2] + k[3] * k[3];
            sq = wave_sum(sq); sk = wave_sum(sk);
            const float rq = rsqrtf(sq * (1.f / 256.f) + EPS), rk = rsqrtf(sk * (1.f / 256.f) + EPS);
            *(u32x2*)(CQN + (size_t)t * 256 + lane * 4) = pack4(q * rq * gq);
            *(u32x2*)(CKVN + (size_t)t * 256 + lane * 4) = pack4(k * rk * gk);
            if (lane < 16) {
                KR[(size_t)t * 32 + lane] = f2bf(x1[j] * cv[j] - x2[j] * sv[j]);
                KR[(size_t)t * 32 + 16 + lane] = f2bf(x1[j] * sv[j] + x2[j] * cv[j]);
            }
        }
    }
}

DEVI void phase_qkv(const Params& p, int, char* lds) {
    { pg8::StaticOrder S; S.init(T_, 768, gdim(), bidx());
      pg8::gemm_phase(lds, pg8::Gemm{WSB(OFF_CQN), WW(W_QB), T_, 768, 256}, S, pg8::EpiStoreBf16{WSB(OFF_Q), 768}); }
    { pg8::StaticOrder S; S.init(T_, 1024, gdim(), bidx());
      pg8::gemm_phase(lds, pg8::Gemm{WSB(OFF_CKVN), WW(W_KVB), T_, 1024, 256}, S, pg8::EpiStoreBf16{WSB(OFF_KV), 1024}); }
}

#define KSWZ(row, colB) ((row) * 256 + ((colB) ^ (((row) & 15) << 4)))
#define SBAR() __builtin_amdgcn_sched_barrier(0)
constexpr int SHM_V = 64 * 128 * 2, SHM_K = 64 * 128 * 2;
DEVI int crow(int r, int hi) { return (r & 3) + 8 * (r >> 2) + 4 * hi; }
DEVI void partialSM(f32x16& p0, f32x16& p1, float& m_reg, float& mn, float& alpha, const float C, const float thr_raw) {
    float pmax = p0[0];
#pragma unroll
    for (int r = 1; r < 16; ++r) pmax = fmaxf(pmax, p0[r]);
#pragma unroll
    for (int r = 0; r < 16; ++r) pmax = fmaxf(pmax, p1[r]);
    { auto rr = __builtin_amdgcn_permlane32_swap(__float_as_uint(pmax), __float_as_uint(pmax), false, false);
      pmax = fmaxf(__uint_as_float(rr[0]), __uint_as_float(rr[1])); }
    if (__builtin_expect(__all(pmax - m_reg <= thr_raw), 1)) { mn = m_reg; alpha = 1.f; }
    else { mn = fmaxf(m_reg, pmax); alpha = __builtin_amdgcn_exp2f((m_reg - mn) * C); m_reg = mn; }
    const float mnC = -mn * C;
#pragma unroll
    for (int r = 0; r < 16; ++r) p0[r] = fmaf(p0[r], C, mnC);
#pragma unroll
    for (int r = 0; r < 16; ++r) p1[r] = fmaf(p1[r], C, mnC);
#pragma unroll
    for (int r = 0; r < 16; ++r) p0[r] = __builtin_amdgcn_exp2f(p0[r]);
}
DEVI void partialSM_shift(f32x16& p0, f32x16& p1, float& moff, float& alpha, bf16x8& qoff, const bool first, const int hi) {
    constexpr float THR2 = 8.f * 1.4426950408889634f;
    float pmax = p0[0];
#pragma unroll
    for (int r = 1; r < 16; ++r) pmax = fmaxf(pmax, p0[r]);
#pragma unroll
    for (int r = 0; r < 16; ++r) pmax = fmaxf(pmax, p1[r]);
    { auto rr = __builtin_amdgcn_permlane32_swap(__float_as_uint(pmax), __float_as_uint(pmax), false, false);
      pmax = fmaxf(__uint_as_float(rr[0]), __uint_as_float(rr[1])); }
    if (__builtin_expect(!first && __all(pmax <= THR2), 1)) { alpha = 1.f; }
    else {
        const float want = moff + (first ? pmax : fmaxf(pmax, 0.f));
        const float mnew = __uint_as_float(pk2(want, 0.f) << 16);
        const float d = mnew - moff; moff = mnew; alpha = __builtin_amdgcn_exp2f(-d);
#pragma unroll
        for (int r = 0; r < 16; ++r) { p0[r] -= d; p1[r] -= d; }
        const unsigned nb = hi == 0 ? ((__float_as_uint(-mnew) >> 16) & 0xffffu) : 0u;
        const u32x4 w = {nb, 0u, 0u, 0u}; qoff = *(const bf16x8*)&w;
    }
#pragma unroll
    for (int r = 0; r < 16; ++r) p0[r] = __builtin_amdgcn_exp2f(p0[r]);
}
DEVI void finishSM(f32x16& p0, f32x16& p1, float alpha, float& l_reg, bf16x8& pa0, bf16x8& pa1, bf16x8& pa2, bf16x8& pa3) {
#pragma unroll
    for (int r = 0; r < 16; ++r) p1[r] = __builtin_amdgcn_exp2f(p1[r]);
    float ps = 0;
#pragma unroll
    for (int r = 0; r < 16; ++r) ps += p0[r];
#pragma unroll
    for (int r = 0; r < 16; ++r) ps += p1[r];
    { auto rr = __builtin_amdgcn_permlane32_swap(__float_as_uint(ps), __float_as_uint(ps), false, false);
      ps = __uint_as_float(rr[0]) + __uint_as_float(rr[1]); }
    l_reg = l_reg * alpha + ps;
#define PK4(P, BASE, OUT) do { unsigned a0 = pk2(P[BASE + 0], P[BASE + 1]), a1 = pk2(P[BASE + 2], P[BASE + 3]);   \
    unsigned b0 = pk2(P[BASE + 4], P[BASE + 5]), b1 = pk2(P[BASE + 6], P[BASE + 7]);                              \
    auto r0 = __builtin_amdgcn_permlane32_swap(a0, b0, false, false); auto r1 = __builtin_amdgcn_permlane32_swap(a1, b1, false, false); \
    u32x4 w = {r0[0], r1[0], r0[1], r1[1]}; OUT = *reinterpret_cast<bf16x8*>(&w); } while (0)
    PK4(p0, 0, pa0); PK4(p0, 8, pa1); PK4(p1, 0, pa2); PK4(p1, 8, pa3);
#undef PK4
}
template <int ND0>
DEVI void qkt(f32x16& p0, f32x16& p1, const bf16_t* Ks, const bf16x8 (&qr)[ND0], int r32, int hi) {
#pragma unroll
    for (int r = 0; r < 16; ++r) { p0[r] = 0.f; p1[r] = 0.f; }
#pragma unroll
    for (int d0 = 0; d0 < ND0; ++d0) {
        const int cb = (d0 * 16 + hi * 8) * 2;
        const bf16x8 b0 = *reinterpret_cast<const bf16x8*>((const char*)Ks + KSWZ(r32, cb));
        const bf16x8 b1 = *reinterpret_cast<const bf16x8*>((const char*)Ks + KSWZ(32 + r32, cb));
        p0 = __builtin_amdgcn_mfma_f32_32x32x16_bf16(b0, qr[d0], p0, 0, 0, 0);
        p1 = __builtin_amdgcn_mfma_f32_32x32x16_bf16(b1, qr[d0], p1, 0, 0, 0);
    }
}
DEVI int v_st(int k, int c) { const int kk = (k & ~0xC) | ((k & 4) << 1) | ((k & 8) >> 1); return ((kk >> 3) * 4 + (c >> 5)) * 512 + ((kk & 7) * 32 + (c & 31)) * 2; }
DEVI int v_rd_base(int lane) { return ((lane & 3) << 3) | (((lane >> 2) & 3) << 6) | (((lane >> 4) & 1) << 5) | (((lane >> 5) & 1) << 8); }
constexpr int v_rd_off(int d0, int ks, int half) { return d0 * 512 + ks * 4096 + half * 2048; }
template <int OFF> DEVI s16x4 tr_read(int vb) {
    s16x4 r; asm volatile("ds_read_b64_tr_b16 %0, %1 offset:%2" : "=&v"(r) : "v"(vb), "i"(OFF) : "memory"); return r;
}
template <int D0> DEVI void pv_one(f32x16& od, int vb, bf16x8 pa0, bf16x8 pa1, bf16x8 pa2, bf16x8 pa3) {
    const s16x4 l0 = tr_read<v_rd_off(D0, 0, 0)>(vb), h0 = tr_read<v_rd_off(D0, 0, 1)>(vb), l1 = tr_read<v_rd_off(D0, 1, 0)>(vb), h1 = tr_read<v_rd_off(D0, 1, 1)>(vb);
    const s16x4 l2 = tr_read<v_rd_off(D0, 2, 0)>(vb), h2 = tr_read<v_rd_off(D0, 2, 1)>(vb), l3 = tr_read<v_rd_off(D0, 3, 0)>(vb), h3 = tr_read<v_rd_off(D0, 3, 1)>(vb);
    asm volatile("s_waitcnt lgkmcnt(0)" ::: "memory"); SBAR();
#define PKV(L, H) (bf16x8){L[0], L[1], L[2], L[3], H[0], H[1], H[2], H[3]}
    od = __builtin_amdgcn_mfma_f32_32x32x16_bf16(pa0, PKV(l0, h0), od, 0, 0, 0);
    od = __builtin_amdgcn_mfma_f32_32x32x16_bf16(pa1, PKV(l1, h1), od, 0, 0, 0);
    od = __builtin_amdgcn_mfma_f32_32x32x16_bf16(pa2, PKV(l2, h2), od, 0, 0, 0);
    od = __builtin_amdgcn_mfma_f32_32x32x16_bf16(pa3, PKV(l3, h3), od, 0, 0, 0);
#undef PKV
}
template <int NDV> DEVI void pv_all(f32x16 (&o)[NDV], int vb, bf16x8 pa0, bf16x8 pa1, bf16x8 pa2, bf16x8 pa3) {
    pv_one<0>(o[0], vb, pa0, pa1, pa2, pa3); pv_one<1>(o[1], vb, pa0, pa1, pa2, pa3);
    if constexpr (NDV == 4) { pv_one<2>(o[2], vb, pa0, pa1, pa2, pa3); pv_one<3>(o[3], vb, pa0, pa1, pa2, pa3); }
}
template <int DQK, int DV, bool SHIFT = false>
DEVI void attn_body(const bf16_t* Qw, const bf16_t* kp, int kstr, bool kact, const bf16_t* vp, int vstr, bool vact,
                    bf16_t* Ow, int ldo, int seq, const float scale, char* lds, const float* qrc = nullptr, const float* qrs = nullptr) {
    constexpr int ND0 = DQK / 16 + (SHIFT ? 1 : 0), NDV = DV / 32;
    const float C = scale * 1.4426950408889634f, thr_raw = 8.f / scale;
    const int tid = tidx(), wid = tid >> 6, lane = tid & 63, r32 = lane & 31, hi = lane >> 5;
    bf16_t* V_lds = (bf16_t*)lds; bf16_t* K_lds = (bf16_t*)(lds + 3 * SHM_V);
    float* wsl = (float*)(lds + 3 * SHM_V + 3 * SHM_K) + wid * 64; float* li_l = wsl; float* al_l = wsl + 32;
    float m_reg = -1e30f, l_reg = 0; f32x16 o[NDV]; bf16x8 qr[ND0];
#pragma unroll
    for (int d = 0; d < NDV; ++d)
#pragma unroll
        for (int r = 0; r < 16; ++r) o[d][r] = 0.f;
#pragma unroll
    for (int d0 = 0; d0 < DQK / 16; ++d0) qr[d0] = *(const bf16x8*)(Qw + d0 * 16);
    if constexpr (SHIFT) qr[ND0 - 1] = (bf16x8){0, 0, 0, 0, 0, 0, 0, 0};
    if constexpr (DQK == 96) {
        if (qrc) {
            float x1[8], x2[8], c[8], sn[8]; unpack8(qr[4], x1); unpack8(qr[5], x2);
            *(f32x4*)&c[0] = *(const f32x4*)qrc; *(f32x4*)&c[4] = *(const f32x4*)(qrc + 4); *(f32x4*)&sn[0] = *(const f32x4*)qrs; *(f32x4*)&sn[4] = *(const f32x4*)(qrs + 4);
            float y1[8], y2[8];
#pragma unroll
            for (int e = 0; e < 8; ++e) { y1[e] = x1[e] * c[e] - x2[e] * sn[e]; y2[e] = x1[e] * sn[e] + x2[e] * c[e]; }
            qr[4] = pack8(y1); qr[5] = pack8(y2);
        }
    }
    const int sr = tid >> 4, sc = (tid & 15) * 8, vst0 = v_st(sr, sc), vst1 = v_st(32 + sr, sc);
    const int vb0 = (int)(uintptr_t)V_lds + v_rd_base(lane);
    bf16x8 vsA0, vsA1, ksA0, ksA1, vsB0, vsB1, ksB0, ksB1;
    vsA0 = vsA1 = ksA0 = ksA1 = vsB0 = vsB1 = ksB0 = ksB1 = (bf16x8){0, 0, 0, 0, 0, 0, 0, 0};
    const int vo0 = vst0, ko0 = 3 * SHM_V + KSWZ(sr, sc * 2);
    static_assert(SHM_V == 16384 && SHM_K == 16384, "staging offsets assume 16 KiB tile images");
    (void)kact; (void)vact;
#define SLOAD(S, k0) do { vs##S##0 = *(const bf16x8*)(vp + (size_t)((k0) + sr) * vstr); vs##S##1 = *(const bf16x8*)(vp + (size_t)((k0) + 32 + sr) * vstr); \
    ks##S##0 = *(const bf16x8*)(kp + (size_t)((k0) + sr) * kstr); ks##S##1 = *(const bf16x8*)(kp + (size_t)((k0) + 32 + sr) * kstr); } while (0)
#define SWRITE(b, S) do { char* base_ = lds + (b) * 16384; *(bf16x8*)(base_ + vo0) = vs##S##0; *(bf16x8*)(base_ + vo0 + 8192) = vs##S##1; \
    *(bf16x8*)(base_ + ko0) = ks##S##0; *(bf16x8*)(base_ + ko0 + 8192) = ks##S##1; } while (0)
#define SWAIT() asm volatile("s_waitcnt vmcnt(4)" ::: "memory")
#define RESC(a) do { if (__any((a) < 1.f)) { if (hi == 0) al_l[r32] = (a); asm volatile("s_waitcnt lgkmcnt(0)" ::: "memory"); \
    _Pragma("unroll") for (int d = 0; d < NDV; ++d) _Pragma("unroll") for (int r = 0; r < 16; ++r) o[d][r] *= al_l[crow(r, hi)]; } } while (0)
    f32x16 pA0, pA1, pB0, pB1; float mnA, mnB, alA, alB; bf16x8 pa0, pa1, pa2, pa3; const int NTL = seq / 64;
    float moff = 0.f;
#define PSM(P0, P1, MN, AL, FIRST) do { if constexpr (SHIFT) partialSM_shift(P0, P1, moff, AL, qr[ND0 - 1], FIRST, hi); else partialSM(P0, P1, m_reg, MN, AL, C, thr_raw); } while (0)
#define KIMG(b) ((bf16_t*)((char*)K_lds + (b) * SHM_K))
#define NXT3(b) ((b) == 2 ? 0 : (b) + 1)
    __syncthreads();
    SLOAD(A, 0); asm volatile("s_waitcnt vmcnt(0)" ::: "memory"); SWRITE(0, A); __syncthreads();
    qkt<ND0>(pA0, pA1, KIMG(0), qr, r32, hi); PSM(pA0, pA1, mnA, alA, true);
    SLOAD(B, 64); SLOAD(A, 128);
    SWAIT(); SWRITE(1, B); __syncthreads();
    int bp = 0, bq = 1, bw = 2;
    for (int j = 1; j + 1 < NTL; j += 2) {
        SBAR(); qkt<ND0>(pB0, pB1, KIMG(bq), qr, r32, hi);
        finishSM(pA0, pA1, alA, l_reg, pa0, pa1, pa2, pa3); SBAR();
        SLOAD(B, (j + 2) * 64); SBAR();
        pv_all<NDV>(o, vb0 + bp * SHM_V, pa0, pa1, pa2, pa3); PSM(pB0, pB1, mnB, alB, false);
        SWAIT(); SWRITE(bw, A);
        RESC(alB); __syncthreads();
        bp = bq; bq = bw; bw = NXT3(bw);
        SBAR(); qkt<ND0>(pA0, pA1, KIMG(bq), qr, r32, hi);
        finishSM(pB0, pB1, alB, l_reg, pa0, pa1, pa2, pa3); SBAR();
        { const int jn = j + 3 < NTL ? j + 3 : NTL - 1; SLOAD(A, jn * 64); } SBAR();
        pv_all<NDV>(o, vb0 + bp * SHM_V, pa0, pa1, pa2, pa3); PSM(pA0, pA1, mnA, alA, false);
        SWAIT(); SWRITE(bw, B);
        RESC(alA); __syncthreads();
        bp = bq; bq = bw; bw = NXT3(bw);
    }
    SBAR(); qkt<ND0>(pB0, pB1, KIMG(bq), qr, r32, hi);
    finishSM(pA0, pA1, alA, l_reg, pa0, pa1, pa2, pa3); SBAR();
    pv_all<NDV>(o, vb0 + bp * SHM_V, pa0, pa1, pa2, pa3); PSM(pB0, pB1, mnB, alB, false);
    RESC(alB);
    finishSM(pB0, pB1, alB, l_reg, pa0, pa1, pa2, pa3); SBAR();
    pv_all<NDV>(o, vb0 + bq * SHM_V, pa0, pa1, pa2, pa3);
#undef KIMG
#undef PSM
#undef NXT3
    if (hi == 0) li_l[r32] = l_reg; asm volatile("s_waitcnt lgkmcnt(0)" ::: "memory");
    float rli[16];
#pragma unroll
    for (int r = 0; r < 16; ++r) rli[r] = __builtin_amdgcn_rcpf(li_l[crow(r, hi)]);
    bf16_t* Owv = Ow + (size_t)(wid * 32) * ldo;
#pragma unroll
    for (int r = 0; r < 16; ++r) { const int orow = crow(r, hi);
#pragma unroll
        for (int d0 = 0; d0 < NDV; ++d0) Owv[(size_t)orow * ldo + d0 * 32 + r32] = f2bf(o[d0][r] * rli[r]); }
#undef SLOAD
#undef SWRITE
#undef SWAIT
#undef RESC
}

template <int OFF> DEVI s16x4 tr_rd(const LAS char* vb) { return __builtin_amdgcn_ds_read_tr16_b64_v4i16((LAS s16x4*)(vb + OFF)); }
template <int ND0, class MID>
DEVI void mphase2(f32x16& p0, f32x16& p1, f32x16 (&o)[2], const LAS char* Ki, const LAS char* vb, const bf16x8 (&qr)[ND0],
                  bf16x8 pa0, bf16x8 pa1, bf16x8 pa2, bf16x8 pa3, int r32, int hi, MID&& mid) {
    static_assert(ND0 >= 5 && ND0 <= 8, "V chunks ride under the last four k-steps");
    bf16x8 kf[ND0][2]; s16x4 vl[2][4], vh[2][4];
#define RK(d) do { const int cb_ = ((d) * 16 + hi * 8) * 2; kf[d][0] = *(const LAS bf16x8*)(Ki + KSWZ(r32, cb_)); kf[d][1] = *(const LAS bf16x8*)(Ki + KSWZ(32 + r32, cb_)); } while (0)
#define RV(c) do { constexpr int d_ = (c) & 1, k_ = ((c) >> 1) * 2; vl[d_][k_] = tr_rd<v_rd_off(d_, k_, 0)>(vb); vh[d_][k_] = tr_rd<v_rd_off(d_, k_, 1)>(vb); \
    vl[d_][k_ + 1] = tr_rd<v_rd_off(d_, k_ + 1, 0)>(vb); vh[d_][k_ + 1] = tr_rd<v_rd_off(d_, k_ + 1, 1)>(vb); } while (0)
    RK(0); RK(1); RK(2); RK(3); SBAR();
#pragma unroll
    for (int r = 0; r < 16; ++r) { p0[r] = 0.f; p1[r] = 0.f; }
#define KS(d) do { p0 = __builtin_amdgcn_mfma_f32_32x32x16_bf16(kf[d][0], qr[d], p0, 0, 0, 0); p1 = __builtin_amdgcn_mfma_f32_32x32x16_bf16(kf[d][1], qr[d], p1, 0, 0, 0); \
    if constexpr ((d) + 4 < ND0) RK(((d) + 4 < ND0 ? (d) + 4 : 0)); else RV(((d) + 4 - ND0) & 3); SBAR(); } while (0)
    KS(0); KS(1); KS(2); KS(3); KS(4);
    if constexpr (ND0 > 5) KS((ND0 > 5 ? 5 : 0));
    if constexpr (ND0 > 6) KS((ND0 > 6 ? 6 : 0));
    if constexpr (ND0 > 7) KS((ND0 > 7 ? 7 : 0));
#undef KS
#undef RK
#undef RV
    mid();
#define PKV(L, H) (bf16x8){L[0], L[1], L[2], L[3], H[0], H[1], H[2], H[3]}
    o[0] = __builtin_amdgcn_mfma_f32_32x32x16_bf16(pa0, PKV(vl[0][0], vh[0][0]), o[0], 0, 0, 0); o[1] = __builtin_amdgcn_mfma_f32_32x32x16_bf16(pa0, PKV(vl[1][0], vh[1][0]), o[1], 0, 0, 0);
    o[0] = __builtin_amdgcn_mfma_f32_32x32x16_bf16(pa1, PKV(vl[0][1], vh[0][1]), o[0], 0, 0, 0); o[1] = __builtin_amdgcn_mfma_f32_32x32x16_bf16(pa1, PKV(vl[1][1], vh[1][1]), o[1], 0, 0, 0);
    o[0] = __builtin_amdgcn_mfma_f32_32x32x16_bf16(pa2, PKV(vl[0][2], vh[0][2]), o[0], 0, 0, 0); o[1] = __builtin_amdgcn_mfma_f32_32x32x16_bf16(pa2, PKV(vl[1][2], vh[1][2]), o[1], 0, 0, 0);
    o[0] = __builtin_amdgcn_mfma_f32_32x32x16_bf16(pa3, PKV(vl[0][3], vh[0][3]), o[0], 0, 0, 0); o[1] = __builtin_amdgcn_mfma_f32_32x32x16_bf16(pa3, PKV(vl[1][3], vh[1][3]), o[1], 0, 0, 0);
#undef PKV
}
template <int DQK, int DV, bool SHIFT = false>
DEVI void attn_body_pp(const bf16_t* Qw, const bf16_t* kp, int kstr, const bf16_t* vp, int vstr,
                       bf16_t* Ow, int ldo, int seq, const float scale, char* lds, const float* qrc = nullptr, const float* qrs = nullptr) {
    constexpr int ND0 = DQK / 16 + (SHIFT ? 1 : 0), NDV = DV / 32;
    const float C = scale * 1.4426950408889634f, thr_raw = 8.f / scale;
    const int tid = tidx(), wid = tid >> 6, lane = tid & 63, r32 = lane & 31, hi = lane >> 5;
    const int g = __builtin_amdgcn_readfirstlane(wid) >> 2;
    bf16_t* V_lds = (bf16_t*)lds; bf16_t* K_lds = (bf16_t*)(lds + 3 * SHM_V);
    float* wsl = (float*)(lds + 3 * SHM_V + 3 * SHM_K) + wid * 64; float* li_l = wsl; float* al_l = wsl + 32;
    float m_reg = -1e30f, l_reg = 0; f32x16 o[NDV]; bf16x8 qr[ND0];
#pragma unroll
    for (int d = 0; d < NDV; ++d)
#pragma unroll
        for (int r = 0; r < 16; ++r) o[d][r] = 0.f;
#pragma unroll
    for (int d0 = 0; d0 < DQK / 16; ++d0) qr[d0] = *(const bf16x8*)(Qw + d0 * 16);
    if constexpr (SHIFT) qr[ND0 - 1] = (bf16x8){0, 0, 0, 0, 0, 0, 0, 0};
    if constexpr (DQK == 96) {
        if (qrc) {
            float x1[8], x2[8], c[8], sn[8]; unpack8(qr[4], x1); unpack8(qr[5], x2);
            *(f32x4*)&c[0] = *(const f32x4*)qrc; *(f32x4*)&c[4] = *(const f32x4*)(qrc + 4); *(f32x4*)&sn[0] = *(const f32x4*)qrs; *(f32x4*)&sn[4] = *(const f32x4*)(qrs + 4);
            float y1[8], y2[8];
#pragma unroll
            for (int e = 0; e < 8; ++e) { y1[e] = x1[e] * c[e] - x2[e] * sn[e]; y2[e] = x1[e] * sn[e] + x2[e] * c[e]; }
            qr[4] = pack8(y1); qr[5] = pack8(y2);
        }
    }
    const int sr = tid >> 4, sc = (tid & 15) * 8, vst0 = v_st(sr, sc);
    const int vb0 = (int)(uintptr_t)V_lds + v_rd_base(lane);
    bf16x8 vsA0, vsA1, ksA0, ksA1, vsB0, vsB1, ksB0, ksB1;
    const int vo0 = vst0, ko0 = 3 * SHM_V + KSWZ(sr, sc * 2);
#define SLOAD(S, k0) do { vs##S##0 = *(const bf16x8*)(vp + (size_t)((k0) + sr) * vstr); vs##S##1 = *(const bf16x8*)(vp + (size_t)((k0) + 32 + sr) * vstr); \
    ks##S##0 = *(const bf16x8*)(kp + (size_t)((k0) + sr) * kstr); ks##S##1 = *(const bf16x8*)(kp + (size_t)((k0) + 32 + sr) * kstr); } while (0)
#define SWRITE(b, S) do { char* base_ = lds + (b) * 16384; *(bf16x8*)(base_ + vo0) = vs##S##0; *(bf16x8*)(base_ + vo0 + 8192) = vs##S##1; \
    *(bf16x8*)(base_ + ko0) = ks##S##0; *(bf16x8*)(base_ + ko0 + 8192) = ks##S##1; } while (0)
#define SWAIT() asm volatile("s_waitcnt vmcnt(4)" ::: "memory")
#define RESC(a) do { if (__any((a) < 1.f)) { if (hi == 0) al_l[r32] = (a); asm volatile("s_waitcnt lgkmcnt(0)" ::: "memory"); \
    _Pragma("unroll") for (int d = 0; d < NDV; ++d) _Pragma("unroll") for (int r = 0; r < 16; ++r) o[d][r] *= al_l[crow(r, hi)]; } } while (0)
    f32x16 p0, p1; float mn, al; bf16x8 pa0, pa1, pa2, pa3; const int NTL = seq / 64;
    pa0 = pa1 = pa2 = pa3 = (bf16x8){0, 0, 0, 0, 0, 0, 0, 0};
    const LAS char* vbl = (const LAS char*)V_lds + v_rd_base(lane);
    float moff = 0.f;
#define PSM(P0, P1, MN, AL, FIRST) do { if constexpr (SHIFT) partialSM_shift(P0, P1, moff, AL, qr[ND0 - 1], FIRST, hi); else partialSM(P0, P1, m_reg, MN, AL, C, thr_raw); } while (0)
#define KIMG(b) ((bf16_t*)((char*)K_lds + (b) * SHM_K))
#define NXT3(b) ((b) == 2 ? 0 : (b) + 1)
    __syncthreads();
    SLOAD(A, 0); SLOAD(B, 64);
    SWAIT(); SWRITE(0, A);
    if (g == 1) { asm volatile("s_waitcnt vmcnt(0)" ::: "memory"); SWRITE(1, B); }
    SLOAD(A, (1 + g) * 64); SLOAD(B, (2 + g) * 64);
    __syncthreads();
    if (g == 1) { SBAR(); __syncthreads(); SBAR(); }
    int iq = 0, ip = 0, iw = 1 + g;
#define STEP(S, k) do { SBAR(); __builtin_amdgcn_s_setprio(1);                                                             \
        if constexpr (NDV == 2) mphase2<ND0>(p0, p1, o, (const LAS char*)K_lds + iq * SHM_K, vbl + ip * SHM_V, qr, pa0, pa1, pa2, pa3, r32, hi, \
                                             [&]() { PSM(p0, p1, mn, al, (k) == 0); });                                    \
        else { qkt<ND0>(p0, p1, KIMG(iq), qr, r32, hi); if ((k) > 0) pv_all<NDV>(o, vb0 + ip * SHM_V, pa0, pa1, pa2, pa3); PSM(p0, p1, mn, al, (k) == 0); }  \
        SBAR(); __builtin_amdgcn_s_setprio(0); __syncthreads(); SBAR();                                                   \
        finishSM(p0, p1, al, l_reg, pa0, pa1, pa2, pa3);                                                                  \
        SWAIT(); if ((k) + 1 + g < NTL) SWRITE(iw, S);                                                                    \
        { const int jn = (k) + 3 + g < NTL ? (k) + 3 + g : NTL - 1; SLOAD(S, jn * 64); }                                  \
        RESC(al); SBAR(); __syncthreads(); SBAR();                                                                        \
        ip = iq; iq = NXT3(iq); iw = NXT3(iw); } while (0)
    for (int k = 0; k < NTL; k += 2) { STEP(A, k); STEP(B, k + 1); }
#undef STEP
    SBAR(); pv_all<NDV>(o, vb0 + ip * SHM_V, pa0, pa1, pa2, pa3);
    if (g == 0) { SBAR(); __syncthreads(); SBAR(); }
#undef KIMG
#undef PSM
#undef NXT3
    if (hi == 0) li_l[r32] = l_reg; asm volatile("s_waitcnt lgkmcnt(0)" ::: "memory");
    float rli[16];
#pragma unroll
    for (int r = 0; r < 16; ++r) rli[r] = __builtin_amdgcn_rcpf(li_l[crow(r, hi)]);
    bf16_t* Owv = Ow + (size_t)(wid * 32) * ldo;
#pragma unroll
    for (int r = 0; r < 16; ++r) { const int orow = crow(r, hi);
#pragma unroll
        for (int d0 = 0; d0 < NDV; ++d0) Owv[(size_t)orow * ldo + d0 * 32 + r32] = f2bf(o[d0][r] * rli[r]); }
#undef SLOAD
#undef SWRITE
#undef SWAIT
#undef RESC
}

DEVI void phase_mla_attn(const Params& p, int, char* lds) {
    const int tid = tidx(), wid = tid >> 6, lane = tid & 63, r32 = lane & 31, hi = lane >> 5;
    const int sc = (tid & 15) * 8;
    const bf16_t* Q = WSB(OFF_Q); const bf16_t* KV = WSB(OFF_KV); const bf16_t* KR = WSB(OFF_KR); bf16_t* O = WSB(OFF_O);
    const int Gn = gdim(), bi = bidx();
    const bool xcd_order = (Gn & 7) == 0 && ((NBATCH * 8 * 16) % Gn) == 0 && (((NBATCH * 8 * 16) / 8) % (Gn >> 3)) == 0;
    for (int u0 = bi, it = 0; u0 < NBATCH * 8 * 16; u0 += Gn, ++it) {
        int u = u0;
        if (xcd_order) { const int xcd = bi & 7, slot = bi >> 3, per = Gn >> 3; u = xcd * ((NBATCH * 8 * 16) >> 3) + it * per + slot; }
        const int qb = u & 15, h = (u >> 4) & 7, b = u >> 7;
        const size_t t0 = (size_t)b * SEQ;
        const bf16_t* Qw = Q + (t0 + qb * 256 + wid * 32 + r32) * 768 + h * 96 + hi * 8;
        const bool kact = sc < 96, vact = sc < 64;
        const bf16_t* kp; int kstr;
        if (sc < 64) { kp = KV + t0 * 1024 + h * 128 + sc; kstr = 1024; } else if (sc < 96) { kp = KR + t0 * 32 + (sc - 64); kstr = 32; }
        else { kp = WSB(OFF_ONES) + (sc - 96); kstr = 0; }
        const bf16_t* vp = KV + t0 * 1024 + h * 128 + 64 + (sc & 63);
        const size_t qtok = t0 + qb * 256 + wid * 32 + r32;
        attn_body_pp<96, 64, true>(Qw, kp, kstr, vp, 1024, O + (t0 + qb * 256) * 512 + h * 64, 512, SEQ, 0.10206207261596577f, lds,
                          WSF(OFF_ROPE_C) + qtok * 16 + hi * 8, WSF(OFF_ROPE_S) + qtok * 16 + hi * 8);
    }
}
DEVI void phase_x_attn(const Params& p, int, char* lds) {
    const int tid = tidx(), wid = tid >> 6, lane = tid & 63, r32 = lane & 31, hi = lane >> 5;
    const int sc = (tid & 15) * 8;
    const bf16_t* Q = WSB(OFF_QX); const bf16_t* KV = WSB(OFF_KVX); bf16_t* O = WSB(OFF_OX);
    for (int u = bidx(); u < NBATCH * 4 * 16; u += gdim()) {
        const int qb = u & 15, h = (u >> 4) & 3, b = u >> 6;
        const size_t t0 = (size_t)b * SEQ;
        const bf16_t* Qw = Q + (t0 + qb * 256 + wid * 32 + r32) * 512 + h * 128 + hi * 8;
        const bf16_t* kp = KV + (size_t)b * 256 * 1024 + h * 256 + sc;
        const bf16_t* vp = kp + 128;
        attn_body<128, 128>(Qw, kp, 1024, true, vp, 1024, true, O + (t0 + qb * 256) * 512 + h * 128, 512, 256, 0.08838834764831845f, lds);
    }
}

DEVI void hy_pre_waves(const Params& p, int l, char* tile_lds, int wv, int nwv) {
    const int tid = tidx(), lane = tid & 63, l8 = lane >> 3, cc = (lane & 7) * 8;
    bf16_t* tile = (bf16_t*)tile_lds;
    const bf16_t* PH = WSB(OFF_PH);
    const float* cw = INF(I_HYCONV) + l * 3 * 1536;
    for (int u = bidx() * nwv + wv; u < 1024 * 24; u += gdim() * nwv) {
        const int cb = u % 24, tb = u / 24, b = tb >> 6, t0 = (tb & 63) * 64;
        const int ch0 = cb * 64 + cc;
        float w0[8], w1[8], w2[8];
#pragma unroll
        for (int e = 0; e < 8; ++e) { w0[e] = cw[ch0 + e]; w1[e] = cw[1536 + ch0 + e]; w2[e] = cw[3072 + ch0 + e]; }
        bf16x8 xv[8][3];
#pragma unroll
        for (int i = 0; i < 8; ++i) {
            const int tt = t0 + l8 + 8 * i;
#pragma unroll
            for (int d = 0; d < 3; ++d) {
                const int ts = tt + d - 1;
                xv[i][d] = (ts >= 0 && ts < SEQ) ? *(const bf16x8*)(PH + ((size_t)b * SEQ + ts) * 1536 + ch0) : (bf16x8){0, 0, 0, 0, 0, 0, 0, 0};
            }
        }
#pragma unroll
        for (int i = 0; i < 8; ++i) {
            float a[8], x0[8], x1[8], x2[8]; unpack8(xv[i][0], x0); unpack8(xv[i][1], x1); unpack8(xv[i][2], x2);
#pragma unroll
            for (int e = 0; e < 8; ++e) a[e] = w0[e] * x0[e] + w1[e] * x1[e] + w2[e] * x2[e];
#pragma unroll
            for (int e = 0; e < 8; ++e) tile[(cc + e) * 72 + l8 + 8 * i] = f2bf(a[e]);
        }
        __builtin_amdgcn_wave_barrier(); asm volatile("s_waitcnt lgkmcnt(0)" ::: "memory");
#pragma unroll
        for (int i = 0; i < 8; ++i) {
            const int cl = l8 + 8 * i, ch = cb * 64 + cl, which = ch >> 9, c = ch & 511;
            bf16_t* dst = WSB(which == 0 ? OFF_VT : (which == 1 ? OFF_X1T : OFF_X2T));
            *(bf16x8*)(dst + ((size_t)c * NBATCH + b) * SEQ + t0 + cc) = *(const bf16x8*)(tile + cl * 72 + cc);
        }
        __builtin_amdgcn_wave_barrier(); asm volatile("s_waitcnt lgkmcnt(0)" ::: "memory");
    }
}
DEVI void phase_s5(const Params& p, int l, char* lds) {
    const int tid = tidx(), wid = tid >> 6, lane = tid & 63, c16 = lane & 15, q4 = lane >> 4;
    if (wid >= 4) { hy_pre_waves(p, l, lds + 51200 + (wid - 4) * 9216, wid - 4, 4); return; }
    f32x2* buS = (f32x2*)(lds + wid * 12800);
    bf16_t* sS = (bf16_t*)(lds + wid * 12800 + 8192);
    const bf16_t* PS = WSB(OFF_PS);
    for (int u = wid * gdim() + bidx(); u < NBATCH * 32 * 2; u += 4 * gdim()) {
        const int dir = u & 1, g = (u >> 1) & 31, b = u >> 6;
        bf16_t* Y = WSB(dir == 0 ? OFF_YSF : OFF_YSB);
        const int gbase = (l * 2 + dir) * 32 + g;
        const float delta = expf(INF(I_S5STEP)[gbase]);
        float lbr, lbi;
        { const float lr = INF(I_S5LRE)[gbase * 64 + lane], li = INF(I_S5LIM)[gbase * 64 + lane];
          const float mag = expf(lr * delta); float sn, cs; sincosf(li * delta, &sn, &cs); lbr = mag * cs; lbi = mag * sn; }
        bf16x8 bre[4], bim[4];
#pragma unroll
        for (int f = 0; f < 4; ++f) {
            const int ps = gbase * 64 + 16 * f + c16;
            const float lr = INF(I_S5LRE)[ps], li = INF(I_S5LIM)[ps];
            const float mag = expf(lr * delta); float sn, cs; sincosf(li * delta, &sn, &cs);
            const float nr = mag * cs - 1.f, ni = mag * sn, den = lr * lr + li * li;
            const float wr_ = (nr * lr + ni * li) / den, wi_ = (ni * lr - nr * li) / den;
            float fr_[8], fi_[8];
#pragma unroll
            for (int e = 0; e < 8; ++e) {
                float x = 0.f, y = 0.f;
                if (q4 < 2) { x = INF(I_S5BRE)[(size_t)ps * 16 + 8 * q4 + e]; y = INF(I_S5BIM)[(size_t)ps * 16 + 8 * q4 + e]; }
                fr_[e] = wr_ * x - wi_ * y; fi_[e] = wr_ * y + wi_ * x;
            }
            bre[f] = pack8(fr_); bim[f] = pack8(fi_);
        }
        bf16x8 cf[4], dfr;
        {
            const float* cre = INF(I_S5CRE) + ((size_t)gbase * 16 + c16) * 64;
            const float* cim = INF(I_S5CIM) + ((size_t)gbase * 16 + c16) * 64;
#pragma unroll
            for (int kb = 0; kb < 4; ++kb) {
                float f[8];
#pragma unroll
                for (int e = 0; e < 8; e += 2) { const int pp = (32 * kb + 8 * q4 + e) >> 1; f[e] = cre[pp]; f[e + 1] = -cim[pp]; }
                cf[kb] = pack8(f);
            }
            const float dsk = (dir == 0) ? INF(I_S5D)[l * 512 + g * 16 + c16] : 0.f;
            float f[8];
#pragma unroll
            for (int e = 0; e < 8; ++e) f[e] = (8 * q4 + e == c16) ? dsk : 0.f;
            dfr = pack8(f);
        }
        float sr = 0.f, si = 0.f;
        const bf16_t* ubase = PS + (size_t)b * SEQ * 512 + g * 16 + 8 * (q4 & 1);
        bf16_t* ybase = Y + (size_t)b * SEQ * 512 + g * 16 + c16;
        auto loadu = [&](int blk) -> bf16x8 {
            const int bc = blk < 256 ? blk : 255;
            const int st = bc * 16 + c16, t = dir == 0 ? st : SEQ - 1 - st;
            return *(const bf16x8*)(ubase + (size_t)t * 512);
        };
        auto projA = [&](const bf16x8 ua) {
#pragma unroll
            for (int f = 0; f < 4; ++f) {
                const f32x4 z = {0.f, 0.f, 0.f, 0.f};
                const f32x4 are = __builtin_amdgcn_mfma_f32_16x16x32_bf16(ua, bre[f], z, 0, 0, 0);
                const f32x4 aim = __builtin_amdgcn_mfma_f32_16x16x32_bf16(ua, bim[f], z, 0, 0, 0);
#pragma unroll
                for (int r = 0; r < 4; ++r) buS[(4 * q4 + r) * 64 + 16 * f + c16] = (f32x2){are[r], aim[r]};
            }
        };
        auto scanB = [&](const f32x2 (&bu)[16]) {
#pragma unroll
            for (int i = 0; i < 16; ++i) {
                const float nsr = fmaf(lbr, sr, fmaf(-lbi, si, bu[i][0])), nsi = fmaf(lbr, si, fmaf(lbi, sr, bu[i][1]));
                sr = nsr; si = nsi;
                *(unsigned*)(sS + i * 136 + 2 * lane) = pk2(sr, si);
            }
        };
        auto outC = [&](const bf16x8 (&a)[4], const bf16x8 up, const int blk) {
            f32x4 acc = {0.f, 0.f, 0.f, 0.f};
            acc = __builtin_amdgcn_mfma_f32_16x16x32_bf16(up, dfr, acc, 0, 0, 0);
#pragma unroll
            for (int kb = 0; kb < 4; ++kb) acc = __builtin_amdgcn_mfma_f32_16x16x32_bf16(a[kb], cf[kb], acc, 0, 0, 0);
#pragma unroll
            for (int r = 0; r < 4; ++r) {
                const int st = blk * 16 + 4 * q4 + r, t = dir == 0 ? st : SEQ - 1 - st;
                ybase[(size_t)t * 512] = f2bf(acc[r]);
            }
        };
        bf16x8 U0 = loadu(0), U1 = loadu(1), U2 = loadu(2), U3 = loadu(3), U4 = loadu(4), U5 = loadu(5), U6 = loadu(6), U7;
        __builtin_amdgcn_wave_barrier();
        projA(U0);
        { f32x2 bu[16];
#pragma unroll
          for (int i = 0; i < 16; ++i) bu[i] = buS[i * 64 + lane];
          projA(U1);
          scanB(bu); }
#define S5STEP(UP, UN, UL, blk_) do { bf16x8 a[4]; f32x2 bu[16];                                                                       \
            _Pragma("unroll") for (int kb = 0; kb < 4; ++kb) a[kb] = *(const bf16x8*)(sS + c16 * 136 + kb * 32 + 8 * q4);     \
            _Pragma("unroll") for (int i = 0; i < 16; ++i) bu[i] = buS[i * 64 + lane];                                            \
            projA(UN);                                                                                                                  \
            outC(a, UP, (blk_) - 1);                                                                                                                       \
            scanB(bu);                                                                                                                                     \
            UL = loadu((blk_) + 6); } while (0)
        asm volatile("" :: "v"(U2), "v"(U3), "v"(U4), "v"(U5), "v"(U6));
#pragma nounroll
        for (int base = 1; base < 257; base += 8) {
            S5STEP(U0, U2, U7, base + 0); S5STEP(U1, U3, U0, base + 1); S5STEP(U2, U4, U1, base + 2); S5STEP(U3, U5, U2, base + 3);
            S5STEP(U4, U6, U3, base + 4); S5STEP(U5, U7, U4, base + 5); S5STEP(U6, U0, U5, base + 6); S5STEP(U7, U1, U6, base + 7);
        }
#undef S5STEP
        __builtin_amdgcn_wave_barrier(); asm volatile("s_waitcnt lgkmcnt(0)" ::: "memory");
    }
}

DEVI void phase_hy_post(const Params& p, int, char* lds) {
    {
        bf16_t* F = WSB(OFF_YSF); const bf16_t* B = WSB(OFF_YSB);
        const size_t n = (size_t)T_ * 64, step = (size_t)gdim() * NTHR;
        for (size_t i = (size_t)bidx() * NTHR + tidx(); i < n; i += 4 * step) {
            bf16x8 fv[4], bv[4];
#pragma unroll
            for (int j = 0; j < 4; ++j) if (i + j * step < n) { fv[j] = *(const bf16x8*)(F + (i + j * step) * 8); bv[j] = *(const bf16x8*)(B + (i + j * step) * 8); }
#pragma unroll
            for (int j = 0; j < 4; ++j) if (i + j * step < n) {
                float x[8], y[8]; unpack8(fv[j], x); unpack8(bv[j], y);
#pragma unroll
                for (int e = 0; e < 8; ++e) x[e] = gelu_tanh(x[e] + y[e]);
                *(bf16x8*)(F + (i + j * step) * 8) = pack8(x);
            }
        }
    }
    const int tid = tidx(), wid = tid >> 6, lane = tid & 63, l8 = lane >> 3, c8 = (lane & 7) * 8;
    bf16_t* tile = (bf16_t*)(lds + wid * 9216);
    const bf16_t* ZT = WSB(OFF_ZT); bf16_t* Z = WSB(OFF_Z);
    for (int u = bidx() * 8 + wid; u < 8 * NBATCH * 64; u += gdim() * 8) {
        const int cb = u & 7, tb = (u >> 3) & 63, b = u >> 9, t0 = tb * 64;
        bf16x8 v[8];
#pragma unroll
        for (int i = 0; i < 8; ++i) v[i] = *(const bf16x8*)(ZT + ((size_t)(cb * 64 + l8 + 8 * i) * NBATCH + b) * SEQ + t0 + c8);
#pragma unroll
        for (int i = 0; i < 8; ++i)
#pragma unroll
            for (int e = 0; e < 8; ++e) tile[(c8 + e) * 72 + l8 + 8 * i] = (bf16_t)v[i][e];
        __builtin_amdgcn_wave_barrier(); asm volatile("s_waitcnt lgkmcnt(0)" ::: "memory");
#pragma unroll
        for (int i = 0; i < 8; ++i) { const int tl = l8 + 8 * i;
            *(bf16x8*)(Z + ((size_t)b * SEQ + t0 + tl) * 512 + cb * 64 + c8) = *(const bf16x8*)(tile + tl * 72 + c8); }
        __builtin_amdgcn_wave_barrier(); asm volatile("s_waitcnt lgkmcnt(0)" ::: "memory");
    }
}

template <int ORD>
DEVI void hy_conv_channel(const Params& p, int l, char* lds, const int c) {
    const int tid = tidx(), wid = tid >> 6, lane = tid & 63, i16 = lane & 15, g = lane >> 4;
    const bf16_t* UT = WSB(ORD == 0 ? OFF_VT : OFF_Z1T);
    const bf16_t* GT = WSB(ORD == 0 ? OFF_X1T : OFF_X2T);
    bf16_t* OT = WSB(ORD == 0 ? OFF_Z1T : OFF_ZT);
    const bf16_t* Rt = WSB(OFF_RTAB) + (size_t)ORD * 512 * 8192;
    const float* biasv = INF(I_HYBIAS) + (l * 2 + ORD) * 512;
    const int q = (8 - (i16 & 7)) & 7;
    const int laneBase = q * 16384 + (4096 - i16 + 8 * g - q) * 2;
    {
        asm volatile("s_waitcnt vmcnt(0)" ::: "memory");
        __syncthreads();
        {
            const bf16_t* R = Rt + (size_t)c * 8192;
#pragma unroll
            for (int it = 0; it < 2; ++it) {
                const int w = tid + 512 * it;
                const u32x4 lo = *(const u32x4*)(R + 8 * w);
                u32x4 hi4 = {0u, 0u, 0u, 0u};
                if (w < 1023) hi4 = *(const u32x4*)(R + 8 * w + 8);
                const unsigned d[8] = {lo[0], lo[1], lo[2], lo[3], hi4[0], hi4[1], hi4[2], hi4[3]};
#pragma unroll
                for (int qq = 0; qq < 8; ++qq) {
                    const int m = qq >> 1;
                    u32x4 o;
                    if ((qq & 1) == 0) { o = (u32x4){d[m], d[m + 1], d[m + 2], d[m + 3]}; }
                    else {
#pragma unroll
                        for (int j = 0; j < 4; ++j) o[j] = __builtin_amdgcn_alignbit(d[m + j + 1], d[m + j], 16);
                    }
                    *(u32x4*)(lds + qq * 16384 + w * 16) = o;
                }
            }
        }
        __syncthreads();
        const float bias = biasv[c];
        const size_t rowb = ((size_t)c * NBATCH + i16) * SEQ;
        for (int hf = 0; hf < 2; ++hf) {
            const int T0 = hf * 2048 + wid * 256;
            f32x4 acc[16];
#pragma unroll
            for (int a = 0; a < 16; ++a) acc[a] = (f32x4){0.f, 0.f, 0.f, 0.f};
            bf16x8 W[16];
            const int base0 = laneBase - 32 * (T0 >> 4);
#pragma unroll
            for (int a = 0; a < 16; ++a) W[a] = *(const bf16x8*)(lds + base0 - 32 * a);
            const bf16_t* up = UT + rowb + 8 * g;
            bf16x8 ub[4];
#pragma unroll
            for (int j = 0; j < 4; ++j) ub[j] = *(const bf16x8*)(up + 32 * j);
            for (int it = 0; it < 16; ++it) {
#pragma unroll
                for (int uu = 0; uu < 8; ++uu) {
                    const int n = it * 8 + uu;
                    if (n > 0) {
                        const int ad = base0 + 64 * n;
                        W[(16 - 2 * uu) & 15] = *(const bf16x8*)(lds + ad);
                        W[(17 - 2 * uu) & 15] = *(const bf16x8*)(lds + ad - 32);
                    }
                    const bf16x8 bcur = ub[uu & 3];
                    if (n + 4 < 128) ub[uu & 3] = *(const bf16x8*)(up + 32 * (n + 4));
#pragma unroll
                    for (int a = 0; a < 16; ++a) acc[a] = __builtin_amdgcn_mfma_f32_16x16x32_bf16(W[(a + 16 - 2 * uu) & 15], bcur, acc[a], 0, 0, 0);
                }
            }
#pragma unroll
            for (int a = 0; a < 16; ++a) {
                const size_t idx = rowb + T0 + 16 * a + 4 * g;
                const u32x2 uv = *(const u32x2*)(UT + idx), gv = *(const u32x2*)(GT + idx);
                f32x4 o;
                o[0] = bflo(gv[0]) * (acc[a][0] + bias * bflo(uv[0]));
                o[1] = bfhi(gv[0]) * (acc[a][1] + bias * bfhi(uv[0]));
                o[2] = bflo(gv[1]) * (acc[a][2] + bias * bflo(uv[1]));
                o[3] = bfhi(gv[1]) * (acc[a][3] + bias * bfhi(uv[1]));
                *(u32x2*)(OT + idx) = pack4(o);
            }
        }
    }
}

DEVI void phase_hy_conv01(const Params& p, int l, char* lds) {
    for (int c = bidx(); c < 512; c += gdim()) { hy_conv_channel<0>(p, l, lds, c); hy_conv_channel<1>(p, l, lds, c); }
}
template <int ORD> DEVI void phase_hy_conv(const Params& p, int l, char* lds) { for (int c = bidx(); c < 512; c += gdim()) hy_conv_channel<ORD>(p, l, lds, c); }

template <int MODE> struct EpiMerge {
    static constexpr bool PERM = true;
    bf16_t* Y; bf16_t* MG; const float* bias;
    DEVI void operator()(const f32x4 (&acc)[2][2][4][2], const pg8::Unit& u, int wr, int wc, int fr, int fq) const {
        const int row0 = u.pm * 256 + wr * 64 + fr, col0 = u.pn * 256 + wc * 32 + 8 * fq;
        float bb[2][8];
        if (MODE >= 2) {
#pragma unroll
            for (int bj = 0; bj < 2; ++bj) { const f32x4 b0 = *(const f32x4*)(bias + col0 + bj * 128), b1 = *(const f32x4*)(bias + col0 + bj * 128 + 4);
#pragma unroll
                for (int e = 0; e < 4; ++e) { bb[bj][e] = b0[e]; bb[bj][4 + e] = b1[e]; } }
        }
#pragma unroll
        for (int ai = 0; ai < 2; ++ai) {
            bf16x8 yv[4][2], gv[4][2];
            if (MODE >= 1) {
#pragma unroll
                for (int m = 0; m < 4; ++m)
#pragma unroll
                    for (int bj = 0; bj < 2; ++bj) { const size_t idx = (size_t)(row0 + ai * 128 + m * 16) * DM + col0 + bj * 128;
                        yv[m][bj] = *(const bf16x8*)(Y + idx); if (MODE == 3) gv[m][bj] = *(const bf16x8*)(MG + idx); }
            }
#pragma unroll
            for (int m = 0; m < 4; ++m)
#pragma unroll
                for (int bj = 0; bj < 2; ++bj) {
                    const size_t idx = (size_t)(row0 + ai * 128 + m * 16) * DM + col0 + bj * 128;
                    float a[8] = {acc[ai][bj][m][0][0], acc[ai][bj][m][0][1], acc[ai][bj][m][0][2], acc[ai][bj][m][0][3],
                                  acc[ai][bj][m][1][0], acc[ai][bj][m][1][1], acc[ai][bj][m][1][2], acc[ai][bj][m][1][3]};
                    if (MODE == 0) {
#pragma unroll
                        for (int e = 0; e < 8; ++e) a[e] = sigmoid_(a[e]);
                        *(bf16x8*)(Y + idx) = pack8(a);
                    } else if (MODE == 1) {
                        float y[8]; unpack8(yv[m][bj], y);
#pragma unroll
                        for (int e = 0; e < 8; ++e) a[e] *= y[e];
                        *(bf16x8*)(Y + idx) = pack8(a);
                    } else {
                        float y[8]; unpack8(yv[m][bj], y);
#pragma unroll
                        for (int e = 0; e < 8; ++e) a[e] = sigmoid_(a[e] + bb[bj][e]) * y[e];
                        if (MODE == 3) { float g[8]; unpack8(gv[m][bj], g);
#pragma unroll
                            for (int e = 0; e < 8; ++e) a[e] += g[e]; }
                        *(bf16x8*)(MG + idx) = pack8(a);
                    }
                }
        }
    }
};
template <int MODE> struct EpiFused {
    static constexpr bool PERM = true;
    bf16_t* MG; const float* bias; char* ldsb;
    static constexpr int NREG = 18;
    mutable unsigned sq[NREG];
    DEVI void operator()(const f32x4 (&acc)[2][2][4][2], const pg8::Unit& u, int st, int wr, int wc, int fr, int fq) const {
        const int row0 = u.pm * 256 + wr * 64 + fr, col0 = u.pn * 256 + wc * 32 + 8 * fq;
        LAS unsigned* sx = (LAS unsigned*)(ldsb + LDS_SQX) + tidx();
        if (st == 0) {
#pragma unroll
            for (int bj = 0; bj < 2; ++bj) {
                const f32x4 b0 = *(const f32x4*)(bias + col0 + bj * 128), b1 = *(const f32x4*)(bias + col0 + bj * 128 + 4);
#pragma unroll
                for (int ai = 0; ai < 2; ++ai)
#pragma unroll
                    for (int m = 0; m < 4; ++m)
#pragma unroll
                        for (int n = 0; n < 2; ++n) {
                            unsigned w = 0;
#pragma unroll
                            for (int q = 0; q < 4; ++q) { const float sv = sigmoid_(acc[ai][bj][m][n][q] + (n ? b1[q] : b0[q]));
                                w |= (unsigned)(sv * 255.f + 0.5f) << (8 * q); }
                            { constexpr int NR = NREG; const int wi = ((ai * 2 + bj) * 4 + m) * 2 + n; if (wi < NR) sq[wi < NR ? wi : 0] = w; else sx[(wi - NR) * 512] = w; }
                        }
            }
        } else {
#pragma unroll
            for (int ai = 0; ai < 2; ++ai) {
                bf16x8 gv[4][2];
                if (MODE == 3) {
#pragma unroll
                    for (int m = 0; m < 4; ++m)
#pragma unroll
                        for (int bj = 0; bj < 2; ++bj) gv[m][bj] = *(const bf16x8*)(MG + (size_t)(row0 + ai * 128 + m * 16) * DM + col0 + bj * 128);
                }
#pragma unroll
                for (int m = 0; m < 4; ++m)
#pragma unroll
                    for (int bj = 0; bj < 2; ++bj) {
                        float a[8];
#pragma unroll
                        for (int n = 0; n < 2; ++n) { const int wi = ((ai * 2 + bj) * 4 + m) * 2 + n; const unsigned w = wi < NREG ? sq[wi < NREG ? wi : 0] : sx[(wi - NREG) * 512];
#pragma unroll
                            for (int q = 0; q < 4; ++q) a[4 * n + q] = acc[ai][bj][m][n][q] * ((float)((w >> (8 * q)) & 0xffu) * (1.f / 255.f)); }
                        if (MODE == 3) { float g[8]; unpack8(gv[m][bj], g);
#pragma unroll
                            for (int e = 0; e < 8; ++e) a[e] += g[e]; }
                        *(bf16x8*)(MG + (size_t)(row0 + ai * 128 + m * 16) * DM + col0 + bj * 128) = pack8(a);
                    }
            }
        }
    }
};
struct MergeDesc {
    static constexpr int NS = 9;
    const char* tab;
    DEVI void get(int st, const char*& A, const char*& B, int& K, int& lda, int& bm, int& ba) const {
        const u32x4 v = *(const LAS u32x4*)((const LAS char*)tab + st * 16);
        A = (const char*)(((unsigned long long)(unsigned)__builtin_amdgcn_readfirstlane((int)v[1]) << 32) | (unsigned)__builtin_amdgcn_readfirstlane((int)v[0]));
        B = (const char*)(((unsigned long long)(unsigned)__builtin_amdgcn_readfirstlane((int)v[3]) << 32) | (unsigned)__builtin_amdgcn_readfirstlane((int)v[2]));
        const bool gate = (st == 0) | (st == 2) | (st == 5) | (st == 7);
        K = gate ? DM : 512; lda = K;
        const bool glu = (st == 3) | (st == 4);
        bm = glu ? 2 : 1; ba = (st == 4) ? 1 : 0;
    }
};
struct EpiFusedN {
    static constexpr bool PERM = true;
    bf16_t* MG; const float* gbias; char* ldsb;
    static constexpr int NREG = 18;
    mutable unsigned sq[NREG];
    DEVI unsigned gw(LAS unsigned* sx, int wi) const { return wi < NREG ? sq[wi < NREG ? wi : 0] : sx[(wi - NREG) * 512]; }
    DEVI void operator()(const f32x4 (&acc)[2][2][4][2], const pg8::Unit& u, int st, int wr, int wc, int fr, int fq) const {
        const int row0 = u.pm * 256 + wr * 64 + fr, col0 = u.pn * 256 + wc * 32 + 8 * fq;
        LAS unsigned* sx = (LAS unsigned*)(ldsb + LDS_SQX) + tidx();
        const bool gate = (st == 0) | (st == 2) | (st == 5) | (st == 7);
        if (gate) {
            const float* bias = gbias + (st == 0 ? 0 : st == 2 ? 1 : st == 5 ? 2 : 3) * DM;
#pragma unroll
            for (int bj = 0; bj < 2; ++bj) {
                const f32x4 b0 = *(const f32x4*)(bias + col0 + bj * 128), b1 = *(const f32x4*)(bias + col0 + bj * 128 + 4);
#pragma unroll
                for (int ai = 0; ai < 2; ++ai)
#pragma unroll
                    for (int m = 0; m < 4; ++m)
#pragma unroll
                        for (int n = 0; n < 2; ++n) {
                            unsigned w = 0;
#pragma unroll
                            for (int q = 0; q < 4; ++q) { const float sv = sigmoid_(acc[ai][bj][m][n][q] + (n ? b1[q] : b0[q]));
                                w |= (unsigned)(sv * 255.f + 0.5f) << (8 * q); }
                            { constexpr int NR = NREG; const int wi = ((ai * 2 + bj) * 4 + m) * 2 + n; if (wi < NR) sq[wi < NR ? wi : 0] = w; else sx[(wi - NR) * 512] = w; }
                        }
            }
        } else if ((st == 3) | (st == 4)) {
            const int h = st - 3;
#pragma unroll
            for (int ai = 0; ai < 2; ++ai) {
                bf16x8 gv[4];
#pragma unroll
                for (int m = 0; m < 4; ++m) gv[m] = *(const bf16x8*)(MG + (size_t)(row0 + ai * 128 + m * 16) * DM + col0 + h * 128);
#pragma unroll
                for (int m = 0; m < 4; ++m) {
                    float a[8], g[8]; unpack8(gv[m], g);
#pragma unroll
                    for (int bj = 0; bj < 2; ++bj) { const unsigned w = h == 0 ? gw(sx, ((ai * 2 + 0) * 4 + m) * 2 + bj) : gw(sx, ((ai * 2 + 1) * 4 + m) * 2 + bj);
#pragma unroll
                        for (int q = 0; q < 4; ++q) a[4 * bj + q] = g[4 * bj + q] + acc[ai][bj][m][0][q] * sigmoid_(acc[ai][bj][m][1][q]) * ((float)((w >> (8 * q)) & 0xffu) * (1.f / 255.f)); }
                    *(bf16x8*)(MG + (size_t)(row0 + ai * 128 + m * 16) * DM + col0 + h * 128) = pack8(a);
                }
            }
        } else {
            const bool accm = st > 1;
#pragma unroll
            for (int ai = 0; ai < 2; ++ai) {
                bf16x8 gv[4][2];
                if (accm) {
#pragma unroll
                    for (int m = 0; m < 4; ++m)
#pragma unroll
                        for (int bj = 0; bj < 2; ++bj) gv[m][bj] = *(const bf16x8*)(MG + (size_t)(row0 + ai * 128 + m * 16) * DM + col0 + bj * 128);
                } else {
#pragma unroll
                    for (int m = 0; m < 4; ++m)
#pragma unroll
                        for (int bj = 0; bj < 2; ++bj) gv[m][bj] = (bf16x8){0, 0, 0, 0, 0, 0, 0, 0};
                }
#pragma unroll
                for (int m = 0; m < 4; ++m)
#pragma unroll
                    for (int bj = 0; bj < 2; ++bj) {
                        float a[8];
#pragma unroll
                        for (int n = 0; n < 2; ++n) { const unsigned w = gw(sx, ((ai * 2 + bj) * 4 + m) * 2 + n);
#pragma unroll
                            for (int q = 0; q < 4; ++q) a[4 * n + q] = acc[ai][bj][m][n][q] * ((float)((w >> (8 * q)) & 0xffu) * (1.f / 255.f)); }
                        { float g[8]; unpack8(gv[m][bj], g);
#pragma unroll
                          for (int e = 0; e < 8; ++e) a[e] += g[e]; }
                        *(bf16x8*)(MG + (size_t)(row0 + ai * 128 + m * 16) * DM + col0 + bj * 128) = pack8(a);
                    }
            }
        }
    }
};
struct GluOrder {
    pg8::StaticOrder S4;
    DEVI bool next(int i, pg8::Unit& u) const { pg8::Unit v; if (!S4.next(i >> 1, v)) return false; u.pm = v.pm; u.pn = 2 * v.pn + (i & 1); return true; }
    DEVI void a_ready(const pg8::Unit&) const {}
    DEVI void done(const pg8::Unit&) const {}
};
struct EpiGlu {
    static constexpr bool PERM = false;
    bf16_t* Y;
    DEVI void operator()(const f32x4 (&acc)[2][2][4][2], const pg8::Unit& u, int wr, int wc, int fr, int fq) const {
        const int row0 = u.pm * 256 + wr * 64 + fr;
#pragma unroll
        for (int ai = 0; ai < 2; ++ai)
#pragma unroll
            for (int m = 0; m < 4; ++m)
#pragma unroll
                for (int bj = 0; bj < 2; ++bj) {
                    const int hc = u.pn * 128 + bj * 64 + wc * 16 + 4 * fq;
                    f32x4 o;
#pragma unroll
                    for (int q = 0; q < 4; ++q) o[q] = acc[ai][bj][m][0][q] * sigmoid_(acc[ai][bj][m][1][q]);
                    *(u32x2*)(Y + (size_t)(row0 + ai * 128 + m * 16) * DM + hc) = pack4(o);
                }
    }
};
DEVI void phase_merge(const Params& p, int l, char* lds) {
    const float* gb = INF(I_GATEB) + l * 4 * DM;
    bf16_t* MG = WSB(OFF_MERGED); bf16_t* YB = WSB(OFF_YB);
    const bf16_t* H = WSB(OFF_H); const bf16_t* YS = WSB(OFF_YSF);
    pg8::StaticOrder S; S.init(T_, DM, gdim(), bidx());
    if (tidx() == 0) {
        const bf16_t** t = (const bf16_t**)(lds + LDS_TAB);
        t[0] = H;  t[1] = WW(W_G);                          t[2] = WSB(OFF_ZA); t[3] = WW(W_OA);
        t[4] = H;  t[5] = WW(W_G) + (size_t)1 * DM * DM;    t[6] = YS;          t[7] = WW(W_GLU);   t[8] = YS; t[9] = WW(W_GLU);
        t[10] = H; t[11] = WW(W_G) + (size_t)2 * DM * DM;   t[12] = WSB(OFF_O); t[13] = WW(W_MO);
        t[14] = H; t[15] = WW(W_G) + (size_t)3 * DM * DM;   t[16] = WSB(OFF_Z); t[17] = WW(W_HO);
    }
    pg8::gemm_phaseN(lds, MergeDesc{lds + LDS_TAB}, S, EpiFusedN{MG, gb, lds, {}});
}

DEVI void phase_mixout(const Params& p, int l, char* lds) {
    pg8::RowPanelOrder S; S.init(T_, DM, gdim(), bidx());
    if (l == 0) pg8::gemm_phase(lds, pg8::Gemm{WSB(OFF_MERGED), WW(W_MIX), T_, DM, DM}, S, pg8::EpiResid<true>{INF(I_X), XB, WSF(OFF_RSS), {}});
    else pg8::gemm_phase(lds, pg8::Gemm{WSB(OFF_MERGED), WW(W_MIX), T_, DM, DM}, S, pg8::EpiResid<false>{nullptr, XB, WSF(OFF_RSS), {}});
}
DEVI void phase_xo(const Params& p, int, char* lds) {
    pg8::RowPanelOrder S; S.init(T_, DM, gdim(), bidx());
    pg8::gemm_phase(lds, pg8::Gemm{WSB(OFF_OX), WW(W_XO), T_, DM, 512}, S, pg8::EpiResid<false>{nullptr, XB, WSF(OFF_RSS) + 4 * T_, {}});
}

DEVI void phase_xqkv(const Params& p, int, char* lds) {
    { pg8::StaticOrder S; S.init(T_, 512, gdim(), bidx());
      pg8::gemm_phase(lds, pg8::Gemm{XB, WW(W_XQ), T_, 512, DM, XLD}, S, pg8::EpiStoreScaled{WSB(OFF_QX), 512, WSF(OFF_RSS)}); }
    { pg8::StaticOrder S; S.init(NBATCH * 256, 1024, gdim(), bidx());
      pg8::gemm_phase(lds, pg8::Gemm{WSB(OFF_MEMN), WW(W_XKV), NBATCH * 256, 1024, DM}, S, pg8::EpiStoreBf16{WSB(OFF_KVX), 1024}); }
}

struct EpiRouter {
    static constexpr bool PERM = false;
    float* LG; const float* rss;
    DEVI void operator()(const f32x4 (&acc)[2][2][4][2], const pg8::Unit& u, int wr, int wc, int fr, int fq) const {
        if (wc >= 2) return;
        const int row0 = u.pm * 256 + wr * 64 + fr, col0 = wc * 32 + 4 * fq;
#pragma unroll
        for (int ai = 0; ai < 2; ++ai)
#pragma unroll
            for (int m = 0; m < 4; ++m) { const int row = row0 + ai * 128 + m * 16; const f32x4 pv = *(const f32x4*)(rss + (size_t)row * 4); const float r = rsqrtf((pv[0] + pv[1] + pv[2] + pv[3]) * (1.f / DM) + EPS);
#pragma unroll
                for (int n = 0; n < 2; ++n) *(f32x4*)(LG + (size_t)row * 64 + col0 + n * 16) = acc[ai][0][m][n] * r; }
    }
};
DEVI void phase_router_gemm(const Params& p, int, char* lds) {
    pg8::StaticOrder S; S.init(T_, 256, gdim(), bidx());
    pg8::gemm_phase(lds, pg8::Gemm{XB, WW(W_RT), T_, 256, DM, XLD}, S, EpiRouter{WSF(OFF_LOGIT), WSF(OFF_RSS) + 4 * T_});
}
DEVI void phase_route(const Params& p, int l, char* lds) {
    const int tid = tidx();
    unsigned* lc = (unsigned*)(lds + LDS_TAB);
    unsigned* gbs = lc + 64;
    unsigned* CNT = WSP(unsigned, OFF_CNT) + l * 64;
    const float* LG = WSF(OFF_LOGIT);
    const float* bg = INF(I_MOEBG) + l * 4; const float* be = INF(I_MOEBE) + l * 32;
    int* LIST = WSP(int, OFF_LIST); float* LW = WSF(OFF_LISTW);
    for (int base = bidx() * NTHR; base < T_; base += gdim() * NTHR) {
        const int tok = base + tid;
        __syncthreads();
        if (tid < 64) lc[tid] = 0u;
        __syncthreads();
        const float* lg = LG + (size_t)tok * 64;
        float gl[4];
#pragma unroll
        for (int i = 0; i < 4; ++i) gl[i] = lg[i] + bg[i];
        int gi = 0; float gm = gl[0];
#pragma unroll
        for (int i = 1; i < 4; ++i) if (gl[i] > gm) { gm = gl[i]; gi = i; }
        float gs = 0.f;
#pragma unroll
        for (int i = 0; i < 4; ++i) gs += expf(gl[i] - gm);
        const float gw = 1.f / gs;
        float el[8];
#pragma unroll
        for (int i = 0; i < 8; ++i) el[i] = lg[4 + gi * 8 + i] + be[gi * 8 + i];
        int i1 = 0; float v1 = el[0];
#pragma unroll
        for (int i = 1; i < 8; ++i) if (el[i] > v1) { v1 = el[i]; i1 = i; }
        int i2 = -1; float v2 = -3.0e38f;
#pragma unroll
        for (int i = 0; i < 8; ++i) if (i != i1 && el[i] > v2) { v2 = el[i]; i2 = i; }
        const float w1 = 1.f / (1.f + expf(v2 - v1)), w2 = 1.f - w1;
        const int ke0 = gi * 8 + i1, ke1 = 32 + gi * 8 + i2;
        const unsigned p0 = atomicAdd(&lc[ke0], 1u), p1 = atomicAdd(&lc[ke1], 1u);
        __syncthreads();
        if (tid < 64) gbs[tid] = lc[tid] ? atomicAdd(&CNT[tid], lc[tid]) : 0u;
        __syncthreads();
        const size_t s0 = (size_t)ke0 * 65536 + gbs[ke0] + p0, s1 = (size_t)ke1 * 65536 + gbs[ke1] + p1;
        LIST[s0] = tok; LW[s0] = w1 * gw;
        LIST[s1] = tok; LW[s1] = w2 * gw;
    }
}
DEVI void moe_tables(const Params& p, int l, char* lds) {
    unsigned* cnt = (unsigned*)(lds + LDS_TAB); unsigned* off = cnt + 64; unsigned* ts = off + 64;
    const unsigned* CNT = WSP(const unsigned, OFF_CNT) + l * 64;
    __syncthreads();
    if (tidx() < 64) cnt[tidx()] = CNT[tidx()];
    __syncthreads();
    if (tidx() == 0) { unsigned o = 0, t = 0; for (int i = 0; i < 64; ++i) { off[i] = o; ts[i] = t; o += cnt[i]; t += (cnt[i] + 255u) >> 8; } ts[64] = t; }
    __syncthreads();
}
struct MoeSched {
    const unsigned* ts;
    int kbeg, kend, nct, G, c;
    DEVI bool next(int i, pg8::Unit& u) const {
        const int L = i * G + c, tb = (int)ts[kbeg], te = (int)ts[kend];
        if (L >= (te - tb) * nct) return false;
        const int tile = tb + L / nct, ct = L % nct;
        int ke = kbeg;
#pragma nounroll
        for (int k = kbeg + 1; k < kend; ++k) if ((int)ts[k] <= tile) ke = k;
        u.pm = tile; u.pn = (ke & 31) * nct + ct; return true;
    }
    DEVI void a_ready(const pg8::Unit&) const {}
    DEVI void done(const pg8::Unit&) const {}
    const unsigned* cnt; const int* LIST;
    DEVI void unit_rows(const pg8::Unit& u, int& ke, int& slot_base, int& n) const {
        int lo = 0, hi = 64;
#pragma nounroll
        while (hi - lo > 1) { const int mid = (lo + hi) >> 1; if ((int)ts[mid] <= u.pm) lo = mid; else hi = mid; }
        ke = lo; slot_base = (u.pm - (int)ts[lo]) * 256; n = (int)cnt[lo];
    }
    DEVI unsigned row_off(int ke, int slot, int n) const {
        const int tok = slot < n ? LIST[(size_t)ke * 65536 + slot] : 0;
        return (unsigned)tok * (unsigned)(XLD * 2);
    }
};
DEVI void phase_moe_gather(const Params& p, int l, char* lds) {
    moe_tables(p, l, lds);
    const unsigned* cnt = (const unsigned*)(lds + LDS_TAB); const unsigned* ts = cnt + 128;
    const int* LIST = WSP(const int, OFF_LIST); const float* LW = WSF(OFF_LISTW);
    float* WG = WSF(OFF_WGT); int* RI = WSP(int, OFF_ROWIDX); float* RSG = WSF(OFF_RSG); const float* rss = WSF(OFF_RSS) + 4 * T_;
    const int nrows = (int)ts[64] * 256;
    for (int r = bidx() * NTHR + tidx(); r < nrows; r += gdim() * NTHR) {
        const int tile = r >> 8;
        int lo = 0, hi = 64;
#pragma nounroll
        while (hi - lo > 1) { const int mid = (lo + hi) >> 1; if ((int)ts[mid] <= tile) lo = mid; else hi = mid; }
        const int slot = r - (int)ts[lo] * 256;
        if (slot < (int)cnt[lo]) { const int tok = LIST[(size_t)lo * 65536 + slot]; WG[r] = LW[(size_t)lo * 65536 + slot]; RI[(size_t)(lo >> 5) * T_ + tok] = r;
            const f32x4 pv = *(const f32x4*)(rss + (size_t)tok * 4); RSG[r] = rsqrtf((pv[0] + pv[1] + pv[2] + pv[3]) * (1.f / DM) + EPS); }
        else { WG[r] = 0.f; RSG[r] = 0.f; }
    }
}
struct EpiMoeGU {
    static constexpr bool PERM = false;
    bf16_t* HB; const float* WG; const float* RSG;
    DEVI void operator()(const f32x4 (&acc)[2][2][4][2], const pg8::Unit& u, int wr, int wc, int fr, int fq) const {
        const int row0 = u.pm * 256 + wr * 64 + fr, ct = u.pn & 1;
#pragma unroll
        for (int ai = 0; ai < 2; ++ai)
#pragma unroll
            for (int m = 0; m < 4; ++m) {
                const int row = row0 + ai * 128 + m * 16;
                asm volatile("" ::: "memory");
                const float w = WG[row], rs = RSG[row], wrs = w * rs;
#pragma unroll
                for (int bj = 0; bj < 2; ++bj) {
                    const int hc = ct * 128 + bj * 64 + wc * 16 + 4 * fq;
                    f32x4 o;
#pragma unroll
                    for (int q = 0; q < 4; ++q) { const float g = acc[ai][bj][m][0][q] * rs; o[q] = g * sigmoid_(g) * acc[ai][bj][m][1][q] * wrs; }
                    *(u32x2*)(HB + (size_t)row * 256 + hc) = pack4(o);
                }
            }
    }
};
DEVI void phase_moe_gu(const Params& p, int l, char* lds) {
    moe_tables(p, l, lds);
    const unsigned* cnt = (const unsigned*)(lds + LDS_TAB); const unsigned* ts = cnt + 128;
    MoeSched S{ts, 0, 64, 2, gdim(), bidx(), cnt, WSP(const int, OFF_LIST)};
    pg8::gemm_phase_gather(lds, pg8::Gemm{XB, WW(W_GU), 0, 0, DM}, S,
                           EpiMoeGU{WSB(OFF_HBUF), WSF(OFF_WGT), WSF(OFF_RSG)});
}
struct EpiMoeDown {
    static constexpr bool PERM = true;
    bf16_t* YD;
    DEVI void operator()(const f32x4 (&acc)[2][2][4][2], const pg8::Unit& u, int wr, int wc, int fr, int fq) const {
        bf16_t* base = YD + (size_t)(u.pm * 256 + wr * 64 + fr) * DM + (u.pn & 3) * 256 + wc * 32 + 8 * fq;
#pragma unroll
        for (int ai = 0; ai < 2; ++ai)
#pragma unroll
            for (int m = 0; m < 4; ++m)
#pragma unroll
                for (int bj = 0; bj < 2; ++bj) {
                    const u32x4 w = {pk2(acc[ai][bj][m][0][0], acc[ai][bj][m][0][1]), pk2(acc[ai][bj][m][0][2], acc[ai][bj][m][0][3]),
                                     pk2(acc[ai][bj][m][1][0], acc[ai][bj][m][1][1]), pk2(acc[ai][bj][m][1][2], acc[ai][bj][m][1][3])};
                    *(u32x4*)(base + (size_t)(ai * 128 + m * 16) * DM + bj * 128) = w; }
    }
};
DEVI void phase_moe_down(const Params& p, int l, char* lds) {
    moe_tables(p, l, lds);
    const unsigned* ts = (const unsigned*)(lds + LDS_TAB) + 128;
    MoeSched S{ts, 0, 64, 4, gdim(), bidx(), nullptr, nullptr};
    pg8::gemm_phase(lds, pg8::Gemm{WSB(OFF_HBUF), WW(W_D), 0, 0, 256}, S, EpiMoeDown{WSB(OFF_YD)});
}
DEVI void phase_final(const Params& p, int, char*) { moe_combine_norm<true>(p, INF(I_FINALNORM), nullptr); }

#define PHASE_LIST(X) \
    X(prologue) X(weights) X(norm_mix) X(pgemm) X(mixA) X(mla_prep) X(qkv) X(mla_attn) X(s5) X(hy_pre) X(hy_conv<0>) X(hy_conv<1>) \
    X(hy_post) X(merge) X(mixout) X(norm_xa) X(xqkv) X(x_attn) X(xo) X(norm_moe) X(router_gemm) X(route) X(moe_gather) X(moe_gu) X(moe_down) X(final)

#if !MEGA
template <int PH>
__global__ void __launch_bounds__(NTHR, 2) k_phase(Params p, int l) {
    extern __shared__ __attribute__((aligned(16))) char lds[];
    if constexpr (PH == 0) phase_prologue(p, l, lds);
    else if constexpr (PH == 1) phase_weights(p, l, lds);
    else if constexpr (PH == 2) phase_norm_mix(p, l, lds);
    else if constexpr (PH == 3) phase_pgemm(p, l, lds);
    else if constexpr (PH == 4) phase_mixA(p, l, lds);
    else if constexpr (PH == 5) phase_mla_prep(p, l, lds);
    else if constexpr (PH == 6) phase_qkv(p, l, lds);
    else if constexpr (PH == 7) phase_mla_attn(p, l, lds);
    else if constexpr (PH == 8) phase_s5(p, l, lds);
    else if constexpr (PH == 9) { }
    else if constexpr (PH == 10) phase_hy_conv<0>(p, l, lds);
    else if constexpr (PH == 11) phase_hy_conv<1>(p, l, lds);
    else if constexpr (PH == 12) phase_hy_post(p, l, lds);
    else if constexpr (PH == 13) phase_merge(p, l, lds);
    else if constexpr (PH == 14) phase_mixout(p, l, lds);
    else if constexpr (PH == 15) phase_norm_xa(p, l, lds);
    else if constexpr (PH == 16) phase_xqkv(p, l, lds);
    else if constexpr (PH == 17) phase_x_attn(p, l, lds);
    else if constexpr (PH == 18) phase_xo(p, l, lds);
    else if constexpr (PH == 19) phase_norm_moe(p, l, lds);
    else if constexpr (PH == 20) phase_router_gemm(p, l, lds);
    else if constexpr (PH == 21) phase_route(p, l, lds);
    else if constexpr (PH == 22) phase_moe_gu(p, l, lds);
    else if constexpr (PH == 23) phase_moe_down(p, l, lds);
    else if constexpr (PH == 25) phase_final(p, l, lds);
    else if constexpr (PH == 26) phase_moe_gather(p, l, lds);
}
template <int PH> static void launch_phase(const Params& p, int l, int grid, hipStream_t s) {
    static bool attr = false;
    if (!attr) { hipFuncSetAttribute((const void*)k_phase<PH>, hipFuncAttributeMaxDynamicSharedMemorySize, LDS_TOTAL); attr = true; }
    hipLaunchKernelGGL(k_phase<PH>, dim3(grid), dim3(NTHR), LDS_TOTAL, s, p, l);
}
#else
__global__ void __launch_bounds__(NTHR, 2) k_mega(Params p) {
    extern __shared__ __attribute__((aligned(16))) char lds[];
    uint4* xbw = (uint4*)(lds + LDS_TAB + 2048);
    if (threadIdx.x == 0) *xbw = make_uint4(0u, 0u, 0u, 0u);
    if ((threadIdx.x & 63) == 0) *(int*)(lds + LDS_WID + ((unsigned)__builtin_amdgcn_s_getreg((5 << 11) | 4) & 63u) * 4) = (int)(threadIdx.x >> 6);
    __syncthreads();
    XcdBarrier bar = xcd_barrier_post((unsigned*)(p.ws + OFF_BAR), (volatile LAS unsigned*)xbw);
#if defined(__HIP_DEVICE_COMPILE__)
#define LOAD_Q() Params q; { typedef const __attribute__((address_space(4))) Params* KParamPtr; KParamPtr kp = (KParamPtr)__builtin_amdgcn_kernarg_segment_ptr(); \
    asm volatile("" : "+s"(kp)); _Pragma("unroll") for (int i_ = 0; i_ < N_INPUTS; ++i_) q.in[i_] = kp->in[i_]; q.out = kp->out; q.ws = kp->ws; }
#else
#define LOAD_Q() Params q = p;
#endif
#define PH_(name) { LOAD_Q(); phase_##name(q, l, lds); } xcd_barrier(bar);
    { const int l = 0; PH_(prologue) }
#pragma nounroll
    for (int l = 0; l < 2; ++l) {
        { LOAD_Q(); phase_weights(q, l, lds); } PH_(norm_mix) PH_(pgemm) { LOAD_Q(); phase_mixA(q, l, lds); } PH_(mla_prep) PH_(qkv) PH_(mla_attn) PH_(s5)
        PH_(hy_conv01) PH_(hy_post) PH_(merge) PH_(mixout) PH_(xqkv) PH_(x_attn) PH_(xo)
        PH_(router_gemm) PH_(route) PH_(moe_gather) PH_(moe_gu) PH_(moe_down)
    }
    { LOAD_Q(); phase_final(q, 0, lds); }
}
#endif


#ifndef DEBUG_NAN
#define DEBUG_NAN 0
#endif
#if DEBUG_NAN
__global__ void k_check(const void* ptr, size_t n, int isf32, unsigned* flags, int idx) {
    size_t i = (size_t)blockIdx.x * blockDim.x + threadIdx.x; const size_t stride = (size_t)gridDim.x * blockDim.x;
    bool bad = false;
    if (isf32) { const unsigned* q = (const unsigned*)ptr; for (; i < n; i += stride) bad |= ((q[i] & 0x7f800000u) >= 0x49800000u); }
    else { const unsigned short* q = (const unsigned short*)ptr; for (; i < n; i += stride) bad |= ((q[i] & 0x7f80u) >= 0x4980u); }
    if (bad) flags[idx] = 1u;
}
__global__ void k_report(float* out, size_t n, const unsigned* flags, int nflags) {
    int f = 0; for (int i = 1; i <= nflags; ++i) if (flags[i]) { f = i; break; }
    for (size_t i = (size_t)blockIdx.x * blockDim.x + threadIdx.x; i < n; i += (size_t)gridDim.x * blockDim.x) out[i] = (float)f;
}
#endif

#if DEBUG_NAN
__global__ void k_count(const void* ptr, size_t n, unsigned long long* cnt) {
    size_t i = (size_t)blockIdx.x * blockDim.x + threadIdx.x; const size_t stride = (size_t)gridDim.x * blockDim.x;
    unsigned long long c = 0; const unsigned short* q = (const unsigned short*)ptr;
    for (; i < n; i += stride) c += ((q[i] & 0x7f80u) >= 0x4980u) ? 1ull : 0ull;
    if (c) atomicAdd(cnt, c);
}
__global__ void k_report2(float* out, size_t n, const unsigned long long* cnt) {
    const unsigned long long c = *cnt; int f = 0; while ((1ull << f) <= c) ++f;
    for (size_t i = (size_t)blockIdx.x * blockDim.x + threadIdx.x; i < n; i += (size_t)gridDim.x * blockDim.x) out[i] = (float)f;
}
#endif

#if DEBUG_NAN
#ifndef DBG_MODE
#define DBG_MODE 1
#endif
__global__ void k_diag(const unsigned short* q, unsigned* masks) {
    size_t i = (size_t)blockIdx.x * blockDim.x + threadIdx.x; const size_t stride = (size_t)gridDim.x * blockDim.x;
    unsigned im = 0, am = 0, bm = 0;
    for (; i < (size_t)T_ * 512; i += stride) {
        if ((q[i] & 0x7f80u) >= 0x4980u) {
            const int row = (int)(i >> 9), col = (int)(i & 511);
            const int pm = row >> 8, pn = col >> 7, u = pm * 4 + pn;
            im |= 1u << (u >> 8);
            am |= 1u << ((((row & 255) >> 6) << 1) | ((col & 127) >> 6));
            bm |= 1u << (u & 7);
        }
    }
    if (im) atomicOr(&masks[0], im);
    if (am) atomicOr(&masks[1], am);
    if (bm) atomicOr(&masks[2], bm);
}
__global__ void k_report3(float* out, size_t n, const unsigned* masks) {
    float f;
    if (DBG_MODE == 0) f = (float)masks[0];
    else if (DBG_MODE == 1) f = (float)__popc(masks[1]) + 10.f * (float)(masks[1] & 1u) + 20.f * (float)((masks[1] >> 7) & 1u);
    else f = (float)__popc(masks[2]);
    for (size_t i = (size_t)blockIdx.x * blockDim.x + threadIdx.x; i < n; i += (size_t)gridDim.x * blockDim.x) out[i] = f;
}
#endif

#if DEBUG_NAN
__global__ void k_wcheck(const unsigned short* w, unsigned* flags, int base) {
    const size_t offs[16] = {W_P, W_G, W_OA, W_GLU, W_QB, W_KVB, W_MO, W_HO, W_MIX, W_XQ, W_XKV, W_XO, W_RT, W_GU, W_D, 40042496};
    for (int m = 0; m < 15; ++m) {
        bool bad = false;
        for (size_t i = offs[m] + (size_t)blockIdx.x * blockDim.x + threadIdx.x; i < offs[m + 1]; i += (size_t)gridDim.x * blockDim.x) bad |= ((w[i] & 0x7f80u) >= 0x4180u);
        if (bad) flags[base + m + 1] = 1u;
    }
}
#endif

#if DEBUG_NAN
__global__ void k_vgemm(const unsigned short* A, int lda, const unsigned short* Bt, int ldb, int K, const unsigned short* C, int ldc, int M, int N, int rstride,
                        unsigned long long* cnt) {
    const int nrows = (M + rstride - 1) / rstride;
    unsigned long long bad = 0;
    for (size_t idx = (size_t)blockIdx.x * blockDim.x + threadIdx.x; idx < (size_t)nrows * N; idx += (size_t)gridDim.x * blockDim.x) {
        const int r = (int)(idx / N) * rstride, c = (int)(idx % N);
        const unsigned short* a = A + (size_t)r * lda; const unsigned short* b = Bt + (size_t)c * ldb;
        float acc = 0.f;
        for (int k = 0; k < K; ++k) acc += __uint_as_float((unsigned)a[k] << 16) * __uint_as_float((unsigned)b[k] << 16);
        const float v = __uint_as_float((unsigned)C[(size_t)r * ldc + c] << 16);
        if (!(fabsf(v - acc) <= 0.05f + 0.02f * fabsf(acc))) ++bad;
    }
    if (bad) atomicAdd(cnt, bad);
}
__global__ void k_report4(float* out, size_t n, const unsigned long long* cnt) {
    int f = 0; { const unsigned long long c = cnt[0]; while ((1ull << f) <= c) ++f; }
    if (f == 0) { int g = 0; const unsigned long long c = cnt[1]; while ((1ull << g) <= c) ++g; if (g) f = 30 + g; }
    for (size_t i = (size_t)blockIdx.x * blockDim.x + threadIdx.x; i < n; i += (size_t)gridDim.x * blockDim.x) out[i] = (float)f;
}
#endif

extern "C" void kernel_launch(void* const* d_in, const int* in_sizes, int n_in, void* d_out, int out_size, void* d_ws, size_t ws_size,
                              hipStream_t stream) {
    if (n_in != N_INPUTS || ws_size < WS_NEED || out_size != T_ * DM) {
        fprintf(stderr, "kernel_launch: unexpected shapes: n_in %d ws %zu out %d\n", n_in, ws_size, out_size);
        return;
    }
    Params p{};
    for (int i = 0; i < N_INPUTS; ++i) p.in[i] = d_in[i];
    p.out = (float*)d_out; p.ws = (char*)d_ws;
    static int grid = 0;
    if (!grid) { int dev = 0, cus = 0; hipGetDevice(&dev); hipDeviceGetAttribute(&cus, hipDeviceAttributeMultiprocessorCount, dev); grid = cus > 0 ? cus : 256; }
#if !MEGA
#if DEBUG_NAN
    unsigned* flags = (unsigned*)(p.ws + OFF_CNT + 4096);
    hipMemsetAsync(flags, 0, 1024, stream);
    int cidx = 0;
    auto chk = [&](size_t off, size_t n, int isf32) { hipLaunchKernelGGL(k_check, dim3(1024), dim3(256), 0, stream, (const void*)(p.ws + off), n, isf32, flags, cidx); };
    auto chko = [&]() { hipLaunchKernelGGL(k_check, dim3(1024), dim3(256), 0, stream, (const void*)p.out, (size_t)T_ * DM, 1, flags, cidx); };
#define CHK(...) do { ++cidx; __VA_ARGS__; } while (0)
#else
#define CHK(...) do { } while (0)
#endif
    const size_t TT = T_;
    launch_phase<0>(p, 0, grid, stream);
    CHK(chk(OFF_ROPE_C, TT * 32, 1); chk(OFF_MEMN, 4096 * 1024, 0));
    for (int l = 0; l < 2; ++l) {
        launch_phase<1>(p, l, grid, stream);  CHK(chk(OFF_W, 40042496, 0); chk(OFF_H2, 4096 * 64, 1));
        launch_phase<2>(p, l, grid, stream);  CHK(chk(OFF_H, TT * 1024, 0));
        launch_phase<3>(p, l, grid, stream);

        CHK(chk(OFF_PA, TT * 1536, 0); chk(OFF_PS, TT * 512, 0); chk(OFF_PM, TT * 640, 0); chk(OFF_PH, TT * 1536, 0); chk(OFF_RTAB, 2 * 512 * 8192, 0));
        launch_phase<4>(p, l, grid, stream);  CHK(chk(OFF_ZA, TT * 512, 0));
        launch_phase<5>(p, l, grid, stream);  CHK(chk(OFF_CQN, TT * 544, 0));
        launch_phase<6>(p, l, grid, stream);  CHK(chk(OFF_Q, TT * 768, 0)); CHK(chk(OFF_KV, TT * 1024, 0));
        launch_phase<7>(p, l, grid, stream);  CHK(chk(OFF_O, TT * 512, 0));
        launch_phase<8>(p, l, grid, stream);  CHK(chk(OFF_YSF, TT * 1024, 0));
        launch_phase<9>(p, l, grid, stream);  CHK(chk(OFF_VT, TT * 1536, 0));
        launch_phase<10>(p, l, grid, stream); CHK(chk(OFF_Z1T, TT * 512, 0));
        launch_phase<11>(p, l, grid, stream); CHK(chk(OFF_ZT, TT * 512, 0));
        launch_phase<12>(p, l, grid, stream); CHK(chk(OFF_Z, TT * 512, 0));
        launch_phase<13>(p, l, grid, stream); CHK(chk(OFF_MERGED, TT * 1024, 0));
        launch_phase<14>(p, l, grid, stream); CHK(chko());
        launch_phase<15>(p, l, grid, stream); CHK(chk(OFF_H, TT * 1024, 0));
        launch_phase<16>(p, l, grid, stream);
 CHK(chk(OFF_QX, TT * 512, 0)); CHK(chk(OFF_KVX, 4096 * 1024, 0));

        launch_phase<17>(p, l, grid, stream); CHK(chk(OFF_OX, TT * 512, 0));
        launch_phase<18>(p, l, grid, stream); CHK(chko());
        launch_phase<19>(p, l, grid, stream); CHK(chk(OFF_H, TT * 1024, 0));
        launch_phase<20>(p, l, grid, stream); CHK(chk(OFF_LOGIT, TT * 64, 1));
        launch_phase<21>(p, l, grid, stream); launch_phase<26>(p, l, grid, stream);
        launch_phase<22>(p, l, grid, stream); CHK(chk(OFF_HBUF, TT * 512, 0));
        launch_phase<23>(p, l, grid, stream);
    }
    launch_phase<25>(p, 0, grid, stream);
#if DEBUG_NAN
    hipLaunchKernelGGL(k_report, dim3(1024), dim3(256), 0, stream, p.out, (size_t)T_ * DM, (const unsigned*)flags, cidx);
#endif
#else
    static bool attr = false;
    if (!attr) { hipFuncSetAttribute((const void*)k_mega, hipFuncAttributeMaxDynamicSharedMemorySize, LDS_TOTAL); attr = true; }
    hipMemsetAsync(p.ws + OFF_BAR, 0, XCD_BAR_WORDS * sizeof(unsigned), stream);
    hipLaunchKernelGGL(k_mega, dim3(grid), dim3(NTHR), LDS_TOTAL, stream, p);
#endif
}
```

```cpp
#include <hip/hip_runtime.h>
#include <stdint.h>
#include <stdio.h>

#ifndef MEGA
#define MEGA 1
#endif

#define DEVI __device__ __forceinline__
typedef unsigned short bf16_t;
typedef short bf16x8 __attribute__((ext_vector_type(8)));
typedef short s16x4 __attribute__((ext_vector_type(4)));
typedef float f32x4 __attribute__((ext_vector_type(4)));
typedef float f32x16 __attribute__((ext_vector_type(16)));
typedef unsigned u32x4 __attribute__((ext_vector_type(4)));
typedef unsigned u32x2 __attribute__((ext_vector_type(2)));

constexpr int T_ = 65536, SEQ = 4096, NBATCH = 16, DM = 1024, NIN = 8224;
constexpr int NTHR = 512;
constexpr float MLA_C = 0.10206207261596577f * 1.4426950408889634f;
constexpr float EPS = 1e-6f;

enum { I_X = 0, I_MEM, I_POS, I_MIXNORM, I_WIN, I_GATEB, I_CONVA, I_WOUTA, I_S5LRE, I_S5LIM, I_S5STEP, I_S5BRE, I_S5BIM,
       I_S5CRE, I_S5CIM, I_S5D, I_S5GLU, I_QNORM, I_WQB, I_KVNORM, I_WKVB, I_MLAWO, I_HYCONV, I_HYW1, I_HYB1, I_HYW2,
       I_HYB2, I_HYW3, I_HYFREQ, I_HYBIAS, I_HYWOUT, I_WMIX, I_XANORM, I_MEMNORM, I_XAWQ, I_XAWKV, I_XAWO, I_MOENORM,
       I_MOEWG, I_MOEBG, I_MOEWE, I_MOEBE, I_MOEGATE, I_MOEUP, I_MOEDOWN, I_FINALNORM, N_INPUTS };

struct Params { const void* in[N_INPUTS]; float* out; char* ws; };
template <class T> DEVI T* G(T* q) { return (T*)(__attribute__((address_space(1))) T*)q; }
#define INF(i) G((const float*)p.in[i])
#define OUTP G(p.out)
#define XB (G((bf16_t*)p.out) + 1024)
constexpr int XLD = 2048;

constexpr size_t MiB = 1ull << 20;
constexpr size_t OFF_BAR = 0;
constexpr size_t OFF_CNT = 64 * 1024;
constexpr size_t OFF_ONES = 128 * 1024;
constexpr size_t OFF_RSS = 167 * MiB;
constexpr size_t OFF_RSG = 589 * MiB;
constexpr size_t OFF_ROPE_C = 1 * MiB;
constexpr size_t OFF_ROPE_S = 5 * MiB;
constexpr size_t OFF_H2 = 9 * MiB;
constexpr size_t OFF_RTAB = 10 * MiB;
constexpr size_t OFF_MEMN = 26 * MiB;
constexpr size_t OFF_KVX = 34 * MiB;
constexpr size_t OFF_LOGIT = 42 * MiB;
constexpr size_t OFF_LIST = 58 * MiB;
constexpr size_t OFF_LISTW = 74 * MiB;
constexpr size_t OFF_W = 90 * MiB;
constexpr size_t OFF_H = 170 * MiB;
constexpr size_t OFF_PH = 298 * MiB;
constexpr size_t OFF_PA = 490 * MiB;
constexpr size_t OFF_PS = 682 * MiB;
constexpr size_t OFF_PM = 890 * MiB;
constexpr size_t OFF_ZA = 826 * MiB;
constexpr size_t OFF_CQN = 746 * MiB, OFF_CKVN = 778 * MiB, OFF_KR = 810 * MiB, OFF_Q = 558 * MiB;
constexpr size_t OFF_KV = 890 * MiB, OFF_O = 746 * MiB;
constexpr size_t OFF_YSF = 890 * MiB, OFF_YSB = 954 * MiB;
constexpr size_t OFF_VT = 490 * MiB, OFF_X1T = 554 * MiB, OFF_X2T = 618 * MiB;
constexpr size_t OFF_Z1T = 298 * MiB, OFF_ZT = 362 * MiB, OFF_Z = 426 * MiB;
constexpr size_t OFF_MERGED = 490 * MiB;
constexpr size_t OFF_YB = 618 * MiB;
constexpr size_t OFF_QX = 298 * MiB, OFF_OX = 362 * MiB;
constexpr size_t OFF_XG = 298 * MiB;
constexpr size_t OFF_WGT = 588 * MiB;
constexpr size_t OFF_YD = 298 * MiB;
constexpr size_t OFF_ROWIDX = 590 * MiB;
constexpr size_t OFF_HBUF = 600 * MiB;
constexpr size_t WS_NEED = 1024 * MiB;
#define WSB(off) G((bf16_t*)(p.ws + (off)))
#define WSF(off) G((float*)(p.ws + (off)))
#define WSP(T, off) G((T*)(p.ws + (off)))

constexpr size_t W_P = 0, W_G = W_P + 4352ull * 1024, W_OA = W_G + 4096ull * 1024, W_GLU = W_OA + 1024ull * 512, W_QB = W_GLU + 2048ull * 512,
                 W_KVB = W_QB + 768ull * 256, W_MO = W_KVB + 1024ull * 256, W_HO = W_MO + 1024ull * 512, W_MIX = W_HO + 1024ull * 512,
                 W_XQ = W_MIX + 1024ull * 1024, W_XKV = W_XQ + 512ull * 1024, W_XO = W_XKV + 1024ull * 1024, W_RT = W_XO + 1024ull * 512,
                 W_GU = W_RT + 256ull * 1024, W_D = W_GU + 32ull * 512 * 1024, W_END = W_D + 32ull * 1024 * 256;
static_assert(W_END * 2 <= 77 * MiB, "weight region overflow (row statistics live at +77 MiB)");
#define WW(o) (WSB(OFF_W) + (o))

constexpr int LDS_TAB = 131072;
constexpr int LDS_SQX = 131072 + 4096;
constexpr int LDS_TOTAL = 131072 + 4096 + 28672;

#if MEGA
constexpr int LDS_WID = 131072 + 3072;
DEVI int tidx() {
    extern __shared__ __attribute__((aligned(16))) char lds_dyn_[];
    const unsigned hw = (unsigned)__builtin_amdgcn_s_getreg((5 << 11) | 4) & 63u;
    const int w = __builtin_amdgcn_readfirstlane(*(const volatile __attribute__((address_space(3))) int*)(lds_dyn_ + LDS_WID + hw * 4));
    int t = (w << 6) | (int)__builtin_amdgcn_mbcnt_hi(~0u, __builtin_amdgcn_mbcnt_lo(~0u, 0u));
    asm volatile("" : "+v"(t)); return t;
}
#else
DEVI int tidx() { int t = threadIdx.x; asm volatile("" : "+v"(t)); return t; }
#endif
DEVI int bidx() { int b = blockIdx.x; asm volatile("" : "+s"(b)); return b; }
DEVI int gdim() { int g = gridDim.x; asm volatile("" : "+s"(g)); return g; }
typedef float f32x2 __attribute__((ext_vector_type(2)));
typedef __bf16 bf16x2n __attribute__((ext_vector_type(2)));
DEVI unsigned pk2(float lo, float hi) { const f32x2 v = {lo, hi}; const bf16x2n b = __builtin_convertvector(v, bf16x2n); return *(const unsigned*)&b; }
DEVI bf16_t f2bf(float v) { return (bf16_t)(pk2(v, 0.f) & 0xffffu); }
DEVI float bflo(unsigned x) { return __uint_as_float(x << 16); }
DEVI float bfhi(unsigned x) { return __uint_as_float(x & 0xffff0000u); }
DEVI float bf2f(bf16_t v) { return __uint_as_float(((unsigned)v) << 16); }
DEVI float wave_sum(float v) {
    const int lane = tidx() & 63;
#pragma unroll
    for (int m = 32; m; m >>= 1) v += __int_as_float(__builtin_amdgcn_ds_bpermute((lane ^ m) << 2, __float_as_int(v)));
    return v;
}
DEVI float sigmoid_(float x) { return __builtin_amdgcn_rcpf(1.f + __builtin_amdgcn_exp2f(-1.4426950408889634f * x)); }
DEVI float gelu_tanh(float x) {
    const float y = 0.7978845608028654f * (x + 0.044715f * x * x * x);
    const float e = __builtin_amdgcn_exp2f(2.8853900817779268f * y);
    return x * (1.f - __builtin_amdgcn_rcpf(1.f + e));
}
DEVI void unpack8(const bf16x8& v, float (&f)[8]) {
    const u32x4 w = *(const u32x4*)&v;
#pragma unroll
    for (int i = 0; i < 4; ++i) { f[2 * i] = bflo(w[i]); f[2 * i + 1] = bfhi(w[i]); }
}
DEVI bf16x8 pack8(const float (&f)[8]) {
    u32x4 w = {pk2(f[0], f[1]), pk2(f[2], f[3]), pk2(f[4], f[5]), pk2(f[6], f[7])};
    return *(bf16x8*)&w;
}
DEVI u32x2 pack4(f32x4 v) { u32x2 r = {pk2(v[0], v[1]), pk2(v[2], v[3])}; return r; }

#define XB_TMO      128
#define XB_XCNT(j)  (256  + 64 * (j))
#define XB_XSUB(j)  (1280 + 64 * (j))
#define XB_XGEN(j)  (2304 + 64 * (j))
#define XB_TOP      3328
#define XB_TOPGEN   3392
#define XCD_BAR_WORDS 3456
#define XB_SPIN_CAP (1u << 27)
#define LAS __attribute__((address_space(3)))

DEVI unsigned xb_ld(unsigned* p) { return __hip_atomic_load(p, __ATOMIC_RELAXED, __HIP_MEMORY_SCOPE_AGENT); }
DEVI unsigned xb_add(unsigned* p, unsigned v) { return __hip_atomic_fetch_add(p, v, __ATOMIC_RELAXED, __HIP_MEMORY_SCOPE_AGENT); }
DEVI unsigned xb_xcc_id() { return (unsigned)__builtin_amdgcn_s_getreg((3 << 11) | 20) & 0xFu; }
#define XB_SPIN(cond, bar) do { unsigned _sp = 0; while (cond) { __builtin_amdgcn_s_sleep(1); \
    if ((++_sp & 255u) == 0u) { if (xb_ld(&(bar)[XB_TMO])) break; if (_sp > XB_SPIN_CAP) { atomicAdd(&(bar)[XB_TMO], 1u); break; } } } } while (0)

struct XcdBarrier { unsigned* bar; unsigned x; volatile LAS unsigned* st; };

DEVI XcdBarrier xcd_barrier_post(unsigned* bar, volatile LAS unsigned* st) {
    XcdBarrier b; b.bar = bar; b.x = xb_xcc_id(); b.st = st;
    if (threadIdx.x == 0) (void)xb_add(&bar[XB_XCNT(b.x)], 1u);
    return b;
}
DEVI void xcd_barrier_complete(unsigned* bar, unsigned x, unsigned& nloc, unsigned& nx) {
    const unsigned G = gridDim.x * gridDim.y * gridDim.z;
    unsigned sum, cnt, mine, sp = 0u;
    for (;;) {
        sum = 0u; cnt = 0u; mine = 0u;
#pragma unroll
        for (unsigned j = 0; j < 16; ++j) { const unsigned c = xb_ld(&bar[XB_XCNT(j)]); sum += c; cnt += (c > 0u) ? 1u : 0u; mine = (j == x) ? c : mine; }
        if (sum == G) break;
        __builtin_amdgcn_s_sleep(1);
        if ((++sp & 255u) == 0u) { if (xb_ld(&bar[XB_TMO])) break; if (sp > XB_SPIN_CAP) { atomicAdd(&bar[XB_TMO], 1u); break; } }
    }
    nloc = mine > 0u ? mine : 1u; nx = cnt > 0u ? cnt : 1u;
}
DEVI void xcd_barrier(const XcdBarrier& b) {
    asm volatile("s_waitcnt vmcnt(0)" ::: "memory");
    __syncthreads();
    if (tidx() == 0) {
        unsigned* bar = b.bar; asm volatile("" : "+s"(bar));
        unsigned bx = b.x; asm volatile("" : "+s"(bx));
        __builtin_amdgcn_s_waitcnt(0);
        unsigned nloc = b.st[0], nx = b.st[1];
        if (nloc == 0u) { xcd_barrier_complete(bar, bx, nloc, nx); b.st[0] = nloc; b.st[1] = nx; }
        const unsigned old = xb_add(&bar[XB_XSUB(bx)], 1u);
        const unsigned gen = old / nloc;
        if (old + 1u == (gen + 1u) * nloc) {
            __builtin_amdgcn_fence(__ATOMIC_RELEASE, "agent");
            asm volatile("s_waitcnt vmcnt(0)" ::: "memory");
            const unsigned og = xb_add(&bar[XB_TOP], 1u);
            const unsigned tg = og / nx;
            if (og + 1u == (tg + 1u) * nx) xb_add(&bar[XB_TOPGEN], 1u);
            else XB_SPIN(xb_ld(&bar[XB_TOPGEN]) == tg, bar);
            __builtin_amdgcn_fence(__ATOMIC_ACQUIRE, "agent");
            xb_add(&bar[XB_XGEN(bx)], 1u);
            asm volatile("s_waitcnt vmcnt(0)" ::: "memory");
        } else {
            XB_SPIN(xb_ld(&bar[XB_XGEN(bx)]) == gen, bar);
            __builtin_amdgcn_fence(__ATOMIC_ACQUIRE, "agent");
            asm volatile("s_waitcnt vmcnt(0)" ::: "memory");
        }
    }
    __syncthreads();
}

constexpr int GBM = 256, GBN = 128, GBK = 64, GLD = 72;
constexpr int G_AS = GBM * GLD * 2, G_BS = GBN * GLD * 2;
template <int NF, class AL, class BL>
DEVI void gemm_kloop_t(f32x4 (&acc)[4][NF], const AL& al, const BL& bl, int K, char* lds) {
    const int tid = tidx(), lane = tid & 63, wid = tid >> 6, wm = wid >> 1, wn = wid & 1;
    bf16_t* As = (bf16_t*)lds; bf16_t* Bs = (bf16_t*)(lds + 2 * G_AS);
    const int srow = tid >> 3, sch = (tid & 7) * 8;
    constexpr int NBL = NF / 2;
    bf16x8 ra[4], rb[NBL];
#define G_LOAD(kk) do { _Pragma("unroll") for (int i = 0; i < 4; ++i) ra[i] = al(i, srow + 64 * i, (kk) + sch); \
                        _Pragma("unroll") for (int i = 0; i < NBL; ++i) rb[i] = bl(i, srow + 64 * i, (kk) + sch); } while (0)
#define G_STORE(buf) do { bf16_t* An_ = As + (buf) * (GBM * GLD); bf16_t* Bn_ = Bs + (buf) * (GBN * GLD); \
                        _Pragma("unroll") for (int i = 0; i < 4; ++i) *(bf16x8*)(An_ + (srow + 64 * i) * GLD + sch) = ra[i]; \
                        _Pragma("unroll") for (int i = 0; i < NBL; ++i) *(bf16x8*)(Bn_ + (srow + 64 * i) * GLD + sch) = rb[i]; } while (0)
    const int nk = K / GBK;
    G_LOAD(0);
    __syncthreads();
    G_STORE(0);
    if (nk > 1) G_LOAD(GBK);
    __syncthreads();
    const int aoff = (wm * 64 + (lane & 15)) * GLD + 8 * (lane >> 4);
    const int boff = (wn * NF * 16 + (lane & 15)) * GLD + 8 * (lane >> 4);
    for (int kt = 0; kt < nk; ++kt) {
        const int cur = kt & 1;
        const bf16_t* Ab = As + cur * (GBM * GLD) + aoff;
        const bf16_t* Bb = Bs + cur * (GBN * GLD) + boff;
#pragma unroll
        for (int ks = 0; ks < 2; ++ks) {
            bf16x8 af[4], bfr[NF];
#pragma unroll
            for (int m = 0; m < 4; ++m) af[m] = *(const bf16x8*)(Ab + m * 16 * GLD + ks * 32);
#pragma unroll
            for (int n = 0; n < NF; ++n) bfr[n] = *(const bf16x8*)(Bb + n * 16 * GLD + ks * 32);
#pragma unroll
            for (int m = 0; m < 4; ++m)
#pragma unroll
                for (int n = 0; n < NF; ++n) acc[m][n] = __builtin_amdgcn_mfma_f32_16x16x32_bf16(bfr[n], af[m], acc[m][n], 0, 0, 0);
            if (ks == 0) {
                __builtin_amdgcn_sched_barrier(0);
                if (kt + 1 < nk) { G_STORE(cur ^ 1); if (kt + 2 < nk) G_LOAD((kt + 2) * GBK); }
                __builtin_amdgcn_sched_barrier(0);
            }
        }
        __syncthreads();
    }
#undef G_LOAD
#undef G_STORE
}
template <class AL, class BL>
DEVI void gemm_kloop(f32x4 (&acc)[4][4], const AL& al, const BL& bl, int K, char* lds) { gemm_kloop_t<4>(acc, al, bl, K, lds); }
struct RowLoader {
    const bf16_t* base; int ld;
    DEVI bf16x8 operator()(int, int r, int k) const { return *(const bf16x8*)(base + (size_t)r * ld + k); }
};
template <int NF>
DEVI void zero_acc(f32x4 (&acc)[4][NF]) {
#pragma unroll
    for (int m = 0; m < 4; ++m)
#pragma unroll
        for (int n = 0; n < NF; ++n) acc[m][n] = (f32x4){0.f, 0.f, 0.f, 0.f};
}


namespace pg8 {
#define PG8_LAS __attribute__((address_space(3)))
constexpr int BM = 256, BK = 64, HALF = 128, HTB = HALF * BK * 2, STAGE_BYTES = 8 * HTB, NXCD = 8, WGM = 8;
DEVI int lds_byte(int r, int c) { const int st = (r >> 4) * 2 + (c >> 5), rr = r & 15, cc = c & 31, ob = rr * 64 + cc * 2; return st * 1024 + (ob ^ (((ob >> 9) & 1) << 5)); }
DEVI void stage_rc(int b, int& R, int& C) { const int st = b / 1024, sb = b % 1024, swz = sb ^ (((sb >> 9) & 1) << 5); R = (st >> 1) * 16 + swz / 64; C = (st & 1) * 32 + (swz % 64) / 2; }
DEVI int perm32(int rho) { const int n = rho >> 4, i = rho & 15; return 8 * (i >> 2) + 4 * n + (i & 3); }
struct Unit { int pm, pn; };
struct Gemm { const bf16_t* A; const bf16_t* Bt; int M, N, K; int lda = 0; };
struct StaticOrder {
    int nM, nN, nwg, G, c;
    DEVI void init(int M, int N, int G_, int c_) { nM = M / BM; nN = N / BM; nwg = nM * nN; G = G_; c = c_; }
    DEVI bool next(int i, Unit& u) const {
        const long L = (long)i * G + c; if (L >= nwg) return false;
        int wgid = (int)L; { const int q = nwg / NXCD, r = nwg % NXCD, xcd = wgid % NXCD, off = wgid / NXCD; wgid = (xcd < r ? xcd * (q + 1) : r * (q + 1) + (xcd - r) * q) + off; }
        const int nig = WGM * nN, gid = wgid / nig, fm = gid * WGM, gsz = (nM - fm) < WGM ? (nM - fm) : WGM;
        u.pm = fm + ((wgid % nig) % gsz); u.pn = (wgid % nig) / gsz; return true;
    }
    DEVI void a_ready(const Unit&) const {}
    DEVI void done(const Unit&) const {}
};
struct RowPanelOrder {
    int nM, nN, G, c;
    DEVI void init(int M, int N, int G_, int c_) { nM = M / BM; nN = N / BM; G = G_; c = c_; }
    DEVI bool next(int i, Unit& u) const { const int pm = c + G * (i / nN); if (pm >= nM) return false; u.pm = pm; u.pn = i % nN; return true; }
    DEVI void a_ready(const Unit&) const {}
    DEVI void done(const Unit&) const {}
};
template <class Epi, class Sched>
DEVI void gemm_phase(char* lds_generic, const Gemm g, const Sched& S, const Epi& E) {
    PG8_LAS unsigned char* lds = (PG8_LAS unsigned char*)lds_generic;
    const int tid = tidx(), wid = __builtin_amdgcn_readfirstlane(tid >> 6), lane = tid & 63, wr = wid >> 2, wc = wid & 3, fr = lane & 15, fq = lane >> 4;
    const int K = g.K, nt = K / BK, lda = g.lda ? g.lda : K;
    unsigned voffA[2], voffB[2];
#pragma unroll
    for (int i = 0; i < 2; ++i) { int R, C; stage_rc(tid * 16 + i * 8192, R, C); const int Rb = Epi::PERM ? ((R & ~31) + perm32(R & 31)) : R;
        voffA[i] = (unsigned)(R * lda + C) * 2u; voffB[i] = (unsigned)(Rb * K + C) * 2u; }
    const size_t kstep = (size_t)(BK * 2);
    const size_t hstep = (size_t)HALF * K * 2, hstepA = (size_t)HALF * lda * 2;
    const size_t tstep = 2 * hstep, tstepA = 2 * hstepA;
    const unsigned ldsw = (unsigned)wid * 1024u;
    const int aoff = lds_byte(wr * 64 + fr, fq * 8), boff = lds_byte(wc * 32 + fr, fq * 8);
#define PG8_SA(b, h) (((b) * 2 + (h)) * HTB)
#define PG8_SB(b, h) ((4 + (b) * 2 + (h)) * HTB)
#define PG8_STAGE(bufoff, gbase, voff) do { _Pragma("unroll") for (int _i = 0; _i < 2; ++_i) \
        __builtin_amdgcn_global_load_lds((const unsigned*)((const char*)(gbase) + (voff)[_i]), (PG8_LAS unsigned*)(lds + (bufoff) + ldsw + _i * 8192), 16, 0, 0); } while (0)
#define PG8_LDA(dst, b, h) do { _Pragma("unroll") for (int m = 0; m < 4; ++m) _Pragma("unroll") for (int k = 0; k < 2; ++k) dst[m][k] = *(const PG8_LAS bf16x8*)(lds + PG8_SA(b, h) + aoff + m * 2048 + k * 1024); } while (0)
#define PG8_LDB(dst, b, h) do { _Pragma("unroll") for (int n = 0; n < 2; ++n) _Pragma("unroll") for (int k = 0; k < 2; ++k) dst[n][k] = *(const PG8_LAS bf16x8*)(lds + PG8_SB(b, h) + boff + n * 2048 + k * 1024); } while (0)
#define PG8_MMA(ai, bj, At, Bt) do { __builtin_amdgcn_s_setprio(1); _Pragma("unroll") for (int m = 0; m < 4; ++m) _Pragma("unroll") for (int n = 0; n < 2; ++n) _Pragma("unroll") for (int k = 0; k < 2; ++k) \
        acc[ai][bj][m][n] = __builtin_amdgcn_mfma_f32_16x16x32_bf16(Bt[n][k], At[m][k], acc[ai][bj][m][n], 0, 0, 0); __builtin_amdgcn_s_setprio(0); } while (0)
#define PG8_WAIT_V(n) asm volatile("s_waitcnt vmcnt(" #n ")" ::: "memory")
#define PG8_WAIT_L(n) asm volatile("s_waitcnt lgkmcnt(" #n ")" ::: "memory")
#define PG8_BAR __builtin_amdgcn_s_barrier()
#define PG8_SCHED __builtin_amdgcn_sched_barrier(0)
    __syncthreads();
    Unit cur, nxt; int ui = 0;
    if (!S.next(0, cur)) return;
    f32x4 acc[2][2][4][2];
#pragma unroll
    for (int a = 0; a < 2; ++a)
#pragma unroll
        for (int b = 0; b < 2; ++b)
#pragma unroll
            for (int m = 0; m < 4; ++m)
#pragma unroll
                for (int n = 0; n < 2; ++n) acc[a][b][m][n] = (f32x4){0.f, 0.f, 0.f, 0.f};
    bf16x8 At[4][2], B0[2][2], B1[2][2];
    const char* cA = (const char*)g.A + (size_t)cur.pm * tstepA; const char* cB = (const char*)g.Bt + (size_t)cur.pn * tstep;
    S.a_ready(cur);
    PG8_STAGE(PG8_SB(0, 0), cB, voffB); PG8_STAGE(PG8_SA(0, 0), cA, voffA); PG8_STAGE(PG8_SB(0, 1), cB + hstep, voffB); PG8_STAGE(PG8_SA(0, 1), cA + hstepA, voffA);
    if (wr == 1) PG8_BAR;
    PG8_WAIT_V(4); PG8_BAR;
    PG8_STAGE(PG8_SB(1, 0), cB + kstep, voffB); PG8_STAGE(PG8_SA(1, 0), cA + kstep, voffA); PG8_STAGE(PG8_SB(1, 1), cB + hstep + kstep, voffB);
    PG8_WAIT_V(6); PG8_BAR;
    for (;;) {
        const bool has_next = S.next(ui + 1, nxt);
        const char* nA = has_next ? (const char*)g.A + (size_t)nxt.pm * tstepA : cA; const char* nB = has_next ? (const char*)g.Bt + (size_t)nxt.pn * tstep : cB;
        for (int t = 0; t < nt; t += 2) {
            const bool last = (t == nt - 2);
            const char* a1 = cA + (size_t)(t + 1) * kstep;
            const char* a2 = last ? nA : cA + (size_t)(t + 2) * kstep; const char* b2 = last ? nB : cB + (size_t)(t + 2) * kstep;
            const char* a3 = a2 + kstep; const char* b3 = b2 + kstep;
            if (last && has_next) S.a_ready(nxt);
            PG8_LDB(B0, 0, 0); PG8_SCHED; PG8_LDA(At, 0, 0); PG8_STAGE(PG8_SA(1, 1), a1 + hstepA, voffA);
            PG8_WAIT_L(8); PG8_BAR; PG8_WAIT_L(0); PG8_MMA(0, 0, At, B0); PG8_BAR; PG8_SCHED;
            PG8_LDB(B1, 0, 1); PG8_STAGE(PG8_SB(0, 0), b2, voffB);
            PG8_BAR; PG8_WAIT_L(0); PG8_MMA(0, 1, At, B1); PG8_BAR;
            PG8_LDA(At, 0, 1); PG8_STAGE(PG8_SA(0, 0), a2, voffA);
            PG8_BAR; PG8_WAIT_L(0); PG8_MMA(1, 0, At, B0); PG8_BAR; PG8_SCHED;
            PG8_STAGE(PG8_SB(0, 1), b2 + hstep, voffB);
            PG8_WAIT_V(6); PG8_BAR; PG8_MMA(1, 1, At, B1); PG8_BAR;
            PG8_LDB(B0, 1, 0); PG8_SCHED; PG8_LDA(At, 1, 0); PG8_STAGE(PG8_SA(0, 1), a2 + hstepA, voffA);
            PG8_WAIT_L(8); PG8_BAR; PG8_WAIT_L(0); PG8_MMA(0, 0, At, B0); PG8_BAR; PG8_SCHED;
            PG8_LDB(B1, 1, 1); PG8_STAGE(PG8_SB(1, 0), b3, voffB);
            PG8_BAR; PG8_WAIT_L(0); PG8_MMA(0, 1, At, B1); PG8_BAR;
            PG8_LDA(At, 1, 1); PG8_STAGE(PG8_SA(1, 0), a3, voffA);
            PG8_BAR; PG8_WAIT_L(0); PG8_MMA(1, 0, At, B0); PG8_BAR; PG8_SCHED;
            PG8_STAGE(PG8_SB(1, 1), b3 + hstep, voffB);
            PG8_WAIT_V(6); PG8_BAR; PG8_MMA(1, 1, At, B1); PG8_BAR;
        }
        E(acc, cur, wr, wc, fr, fq); S.done(cur);
        if (!has_next) break;
#pragma unroll
        for (int a = 0; a < 2; ++a)
#pragma unroll
            for (int b = 0; b < 2; ++b)
#pragma unroll
                for (int m = 0; m < 4; ++m)
#pragma unroll
                    for (int n = 0; n < 2; ++n) acc[a][b][m][n] = (f32x4){0.f, 0.f, 0.f, 0.f};
        cur = nxt; cA = nA; cB = nB; ++ui;
    }
    PG8_WAIT_V(0);
    if (wr == 0) PG8_BAR;
    PG8_BAR;
#undef PG8_SA
#undef PG8_SB
#undef PG8_STAGE
#undef PG8_LDA
#undef PG8_LDB
#undef PG8_MMA
#undef PG8_WAIT_V
#undef PG8_WAIT_L
#undef PG8_BAR
#undef PG8_SCHED
}
template <class Epi, class Sched>
DEVI void gemm_phase2(char* lds_generic, const Gemm g0, const Gemm g1, const Sched& S, const Epi& E) {
    PG8_LAS unsigned char* lds = (PG8_LAS unsigned char*)lds_generic;
    const int tid = tidx(), wid = __builtin_amdgcn_readfirstlane(tid >> 6), lane = tid & 63, wr = wid >> 2, wc = wid & 3, fr = lane & 15, fq = lane >> 4;
    const int K0 = g0.K, K1 = g1.K, nt0 = K0 / BK, nt1 = K1 / BK, lda0 = g0.lda ? g0.lda : K0, lda1 = g1.lda ? g1.lda : K1;
    unsigned R2[2], Rb2[2], C2[2];
#pragma unroll
    for (int i = 0; i < 2; ++i) { int R, C; stage_rc(tid * 16 + i * 8192, R, C); const int Rb = Epi::PERM ? ((R & ~31) + perm32(R & 31)) : R;
        R2[i] = (unsigned)R * 2u; Rb2[i] = (unsigned)Rb * 2u; C2[i] = (unsigned)C * 2u; }
    const size_t kstep = (size_t)(BK * 2);
    const unsigned ldsw = (unsigned)wid * 1024u;
    const int aoff = lds_byte(wr * 64 + fr, fq * 8), boff = lds_byte(wc * 32 + fr, fq * 8);
#define PG8_SA(b, h) (((b) * 2 + (h)) * HTB)
#define PG8_SB(b, h) ((4 + (b) * 2 + (h)) * HTB)
#define PG8_STAGE(bufoff, gbase, RR, ld) do { _Pragma("unroll") for (int _i = 0; _i < 2; ++_i) \
        __builtin_amdgcn_global_load_lds((const unsigned*)((const char*)(gbase) + (RR[_i] * (unsigned)(ld) + C2[_i])), (PG8_LAS unsigned*)(lds + (bufoff) + ldsw + _i * 8192), 16, 0, 0); } while (0)
#define PG8_LDA(dst, b, h) do { _Pragma("unroll") for (int m = 0; m < 4; ++m) _Pragma("unroll") for (int k = 0; k < 2; ++k) dst[m][k] = *(const PG8_LAS bf16x8*)(lds + PG8_SA(b, h) + aoff + m * 2048 + k * 1024); } while (0)
#define PG8_LDB(dst, b, h) do { _Pragma("unroll") for (int n = 0; n < 2; ++n) _Pragma("unroll") for (int k = 0; k < 2; ++k) dst[n][k] = *(const PG8_LAS bf16x8*)(lds + PG8_SB(b, h) + boff + n * 2048 + k * 1024); } while (0)
#define PG8_MMA(ai, bj, At, Bt) do { __builtin_amdgcn_s_setprio(1); _Pragma("unroll") for (int m = 0; m < 4; ++m) _Pragma("unroll") for (int n = 0; n < 2; ++n) _Pragma("unroll") for (int k = 0; k < 2; ++k) \
        acc[ai][bj][m][n] = __builtin_amdgcn_mfma_f32_16x16x32_bf16(Bt[n][k], At[m][k], acc[ai][bj][m][n], 0, 0, 0); __builtin_amdgcn_s_setprio(0); } while (0)
#define PG8_WAIT_V(n) asm volatile("s_waitcnt vmcnt(" #n ")" ::: "memory")
#define PG8_WAIT_L(n) asm volatile("s_waitcnt lgkmcnt(" #n ")" ::: "memory")
#define PG8_BAR __builtin_amdgcn_s_barrier()
#define PG8_SCHED __builtin_amdgcn_sched_barrier(0)
    __syncthreads();
    Unit cur, nxt; int ui = 0;
    if (!S.next(0, cur)) return;
    f32x4 acc[2][2][4][2];
#pragma unroll
    for (int a = 0; a < 2; ++a)
#pragma unroll
        for (int b = 0; b < 2; ++b)
#pragma unroll
            for (int m = 0; m < 4; ++m)
#pragma unroll
                for (int n = 0; n < 2; ++n) acc[a][b][m][n] = (f32x4){0.f, 0.f, 0.f, 0.f};
    bf16x8 At[4][2], B0[2][2], B1[2][2];
    const char* cA = (const char*)g0.A + (size_t)cur.pm * (size_t)(2 * HALF) * lda0 * 2; const char* cB = (const char*)g0.Bt + (size_t)cur.pn * (size_t)(2 * HALF) * K0 * 2;
    { const size_t hB = (size_t)HALF * K0 * 2, hA = (size_t)HALF * lda0 * 2;
      PG8_STAGE(PG8_SB(0, 0), cB, Rb2, K0); PG8_STAGE(PG8_SA(0, 0), cA, R2, lda0); PG8_STAGE(PG8_SB(0, 1), cB + hB, Rb2, K0); PG8_STAGE(PG8_SA(0, 1), cA + hA, R2, lda0);
      if (wr == 1) PG8_BAR;
      PG8_WAIT_V(4); PG8_BAR;
      PG8_STAGE(PG8_SB(1, 0), cB + kstep, Rb2, K0); PG8_STAGE(PG8_SA(1, 0), cA + kstep, R2, lda0); PG8_STAGE(PG8_SB(1, 1), cB + hB + kstep, Rb2, K0);
      PG8_WAIT_V(6); PG8_BAR; }
    for (;;) {
        const int st = ui & 1;
        bool has_next; const char* nA; const char* nB;
        if (st == 0) { has_next = true; nxt = cur; nA = (const char*)g1.A + (size_t)cur.pm * (size_t)(2 * HALF) * lda1 * 2; nB = (const char*)g1.Bt + (size_t)cur.pn * (size_t)(2 * HALF) * K1 * 2; }
        else { has_next = S.next((ui + 1) >> 1, nxt);
               nA = has_next ? (const char*)g0.A + (size_t)nxt.pm * (size_t)(2 * HALF) * lda0 * 2 : cA; nB = has_next ? (const char*)g0.Bt + (size_t)nxt.pn * (size_t)(2 * HALF) * K0 * 2 : cB; }
        const int nt = st ? nt1 : nt0, ldAc = st ? lda1 : lda0, ldBc = st ? K1 : K0, ldAn = st ? lda0 : lda1, ldBn = st ? K0 : K1;
        const size_t hAc = (size_t)HALF * ldAc * 2;
        for (int t = 0; t < nt; t += 2) {
            const bool last = (t == nt - 2);
            const char* a1 = cA + (size_t)(t + 1) * kstep;
            const char* a2 = last ? nA : cA + (size_t)(t + 2) * kstep; const char* b2 = last ? nB : cB + (size_t)(t + 2) * kstep;
            const char* a3 = a2 + kstep; const char* b3 = b2 + kstep;
            const int ldA2 = last ? ldAn : ldAc, ldB2 = last ? ldBn : ldBc;
            const size_t hA2 = (size_t)HALF * ldA2 * 2, hB2 = (size_t)HALF * ldB2 * 2;
            PG8_LDB(B0, 0, 0); PG8_SCHED; PG8_LDA(At, 0, 0); PG8_STAGE(PG8_SA(1, 1), a1 + hAc, R2, ldAc);
            PG8_WAIT_L(8); PG8_BAR; PG8_WAIT_L(0); PG8_MMA(0, 0, At, B0); PG8_BAR; PG8_SCHED;
            PG8_LDB(B1, 0, 1); PG8_STAGE(PG8_SB(0, 0), b2, Rb2, ldB2);
            PG8_BAR; PG8_WAIT_L(0); PG8_MMA(0, 1, At, B1); PG8_BAR;
            PG8_LDA(At, 0, 1); PG8_STAGE(PG8_SA(0, 0), a2, R2, ldA2);
            PG8_BAR; PG8_WAIT_L(0); PG8_MMA(1, 0, At, B0); PG8_BAR; PG8_SCHED;
            PG8_STAGE(PG8_SB(0, 1), b2 + hB2, Rb2, ldB2);
            PG8_WAIT_V(6); PG8_BAR; PG8_MMA(1, 1, At, B1); PG8_BAR;
            PG8_LDB(B0, 1, 0); PG8_SCHED; PG8_LDA(At, 1, 0); PG8_STAGE(PG8_SA(0, 1), a2 + hA2, R2, ldA2);
            PG8_WAIT_L(8); PG8_BAR; PG8_WAIT_L(0); PG8_MMA(0, 0, At, B0); PG8_BAR; PG8_SCHED;
            PG8_LDB(B1, 1, 1); PG8_STAGE(PG8_SB(1, 0), b3, Rb2, ldB2);
            PG8_BAR; PG8_WAIT_L(0); PG8_MMA(0, 1, At, B1); PG8_BAR;
            PG8_LDA(At, 1, 1); PG8_STAGE(PG8_SA(1, 0), a3, R2, ldA2);
            PG8_BAR; PG8_WAIT_L(0); PG8_MMA(1, 0, At, B0); PG8_BAR; PG8_SCHED;
            PG8_STAGE(PG8_SB(1, 1), b3 + hB2, Rb2, ldB2);
            PG8_WAIT_V(6); PG8_BAR; PG8_MMA(1, 1, At, B1); PG8_BAR;
        }
        E(acc, cur, st, wr, wc, fr, fq);
        if (!has_next) break;
#pragma unroll
        for (int a = 0; a < 2; ++a)
#pragma unroll
            for (int b = 0; b < 2; ++b)
#pragma unroll
                for (int m = 0; m < 4; ++m)
#pragma unroll
                    for (int n = 0; n < 2; ++n) acc[a][b][m][n] = (f32x4){0.f, 0.f, 0.f, 0.f};
        cur = nxt; cA = nA; cB = nB; ++ui;
    }
    PG8_WAIT_V(0);
    if (wr == 0) PG8_BAR;
    PG8_BAR;
#undef PG8_SA
#undef PG8_SB
#undef PG8_STAGE
#undef PG8_LDA
#undef PG8_LDB
#undef PG8_MMA
#undef PG8_WAIT_V
#undef PG8_WAIT_L
#undef PG8_BAR
#undef PG8_SCHED
}
template <class Epi, class Sched, class Desc>
DEVI void gemm_phaseN(char* lds_generic, const Desc& D, const Sched& S, const Epi& E) {
    PG8_LAS unsigned char* lds = (PG8_LAS unsigned char*)lds_generic;
    const int tid = tidx(), wid = __builtin_amdgcn_readfirstlane(tid >> 6), lane = tid & 63, wr = wid >> 2, wc = wid & 3, fr = lane & 15, fq = lane >> 4;
    unsigned R2[2], Rb2[2], C2[2];
#pragma unroll
    for (int i = 0; i < 2; ++i) { int R, C; stage_rc(tid * 16 + i * 8192, R, C); const int Rb = Epi::PERM ? ((R & ~31) + perm32(R & 31)) : R;
        R2[i] = (unsigned)R * 2u; Rb2[i] = (unsigned)Rb * 2u; C2[i] = (unsigned)C * 2u; }
    const size_t kstep = (size_t)(BK * 2);
    const unsigned ldsw = (unsigned)wid * 1024u;
    const int aoff = lds_byte(wr * 64 + fr, fq * 8), boff = lds_byte(wc * 32 + fr, fq * 8);
#define PG8_SA(b, h) (((b) * 2 + (h)) * HTB)
#define PG8_SB(b, h) ((4 + (b) * 2 + (h)) * HTB)
#define PG8_STAGE(bufoff, gbase, RR, ld) do { _Pragma("unroll") for (int _i = 0; _i < 2; ++_i) \
        __builtin_amdgcn_global_load_lds((const unsigned*)((const char*)(gbase) + (RR[_i] * (unsigned)(ld) + C2[_i])), (PG8_LAS unsigned*)(lds + (bufoff) + ldsw + _i * 8192), 16, 0, 0); } while (0)
#define PG8_LDA(dst, b, h) do { _Pragma("unroll") for (int m = 0; m < 4; ++m) _Pragma("unroll") for (int k = 0; k < 2; ++k) dst[m][k] = *(const PG8_LAS bf16x8*)(lds + PG8_SA(b, h) + aoff + m * 2048 + k * 1024); } while (0)
#define PG8_LDB(dst, b, h) do { _Pragma("unroll") for (int n = 0; n < 2; ++n) _Pragma("unroll") for (int k = 0; k < 2; ++k) dst[n][k] = *(const PG8_LAS bf16x8*)(lds + PG8_SB(b, h) + boff + n * 2048 + k * 1024); } while (0)
#define PG8_MMA(ai, bj, At, Bt) do { __builtin_amdgcn_s_setprio(1); _Pragma("unroll") for (int m = 0; m < 4; ++m) _Pragma("unroll") for (int n = 0; n < 2; ++n) _Pragma("unroll") for (int k = 0; k < 2; ++k) \
        acc[ai][bj][m][n] = __builtin_amdgcn_mfma_f32_16x16x32_bf16(Bt[n][k], At[m][k], acc[ai][bj][m][n], 0, 0, 0); __builtin_amdgcn_s_setprio(0); } while (0)
#define PG8_WAIT_V(n) asm volatile("s_waitcnt vmcnt(" #n ")" ::: "memory")
#define PG8_WAIT_L(n) asm volatile("s_waitcnt lgkmcnt(" #n ")" ::: "memory")
#define PG8_BAR __builtin_amdgcn_s_barrier()
#define PG8_SCHED __builtin_amdgcn_sched_barrier(0)
    __syncthreads();
    const char* A0_; const char* B0_; int K0, lda0, bm0, ba0; D.get(0, A0_, B0_, K0, lda0, bm0, ba0);
    Unit cur, nxt; int ti = 0, st = 0;
    if (!S.next(0, cur)) return;
    f32x4 acc[2][2][4][2];
#pragma unroll
    for (int a = 0; a < 2; ++a)
#pragma unroll
        for (int b = 0; b < 2; ++b)
#pragma unroll
            for (int m = 0; m < 4; ++m)
#pragma unroll
                for (int n = 0; n < 2; ++n) acc[a][b][m][n] = (f32x4){0.f, 0.f, 0.f, 0.f};
    bf16x8 At[4][2], B0[2][2], B1[2][2];
    const char* cA = A0_ + (size_t)cur.pm * (size_t)(2 * HALF) * lda0 * 2; const char* cB = B0_ + (size_t)(cur.pn * bm0 + ba0) * (size_t)(2 * HALF) * K0 * 2;
    { const size_t hB = (size_t)HALF * K0 * 2, hA = (size_t)HALF * lda0 * 2;
      PG8_STAGE(PG8_SB(0, 0), cB, Rb2, K0); PG8_STAGE(PG8_SA(0, 0), cA, R2, lda0); PG8_STAGE(PG8_SB(0, 1), cB + hB, Rb2, K0); PG8_STAGE(PG8_SA(0, 1), cA + hA, R2, lda0);
      if (wr == 1) PG8_BAR;
      PG8_WAIT_V(4); PG8_BAR;
      PG8_STAGE(PG8_SB(1, 0), cB + kstep, Rb2, K0); PG8_STAGE(PG8_SA(1, 0), cA + kstep, R2, lda0); PG8_STAGE(PG8_SB(1, 1), cB + hB + kstep, Rb2, K0);
      PG8_WAIT_V(6); PG8_BAR; }
    for (;;) {
        const int sn = (st + 1 == Desc::NS) ? 0 : st + 1;
        bool has_next = true; nxt = cur;
        if (sn == 0) has_next = S.next(ti + 1, nxt);
        const char* Ac_; const char* Bc_; int Kc, ldAc, bmc, bac; D.get(st, Ac_, Bc_, Kc, ldAc, bmc, bac);
        const char* An_; const char* Bn_; int Kn, ldAn, bmn, ban; D.get(sn, An_, Bn_, Kn, ldAn, bmn, ban);
        const char* nA = has_next ? An_ + (size_t)nxt.pm * (size_t)(2 * HALF) * ldAn * 2 : cA; const char* nB = has_next ? Bn_ + (size_t)(nxt.pn * bmn + ban) * (size_t)(2 * HALF) * Kn * 2 : cB;
        const int nt = Kc / BK, ldBc = Kc, ldBn = Kn;
        const size_t hAc = (size_t)HALF * ldAc * 2;
        for (int t = 0; t < nt; t += 2) {
            const bool last = (t == nt - 2);
            const char* a1 = cA + (size_t)(t + 1) * kstep;
            const char* a2 = last ? nA : cA + (size_t)(t + 2) * kstep; const char* b2 = last ? nB : cB + (size_t)(t + 2) * kstep;
            const char* a3 = a2 + kstep; const char* b3 = b2 + kstep;
            const int ldA2 = last ? ldAn : ldAc, ldB2 = last ? ldBn : ldBc;
            const size_t hA2 = (size_t)HALF * ldA2 * 2, hB2 = (size_t)HALF * ldB2 * 2;
            PG8_LDB(B0, 0, 0); PG8_SCHED; PG8_LDA(At, 0, 0); PG8_STAGE(PG8_SA(1, 1), a1 + hAc, R2, ldAc);
            PG8_WAIT_L(8); PG8_BAR; PG8_WAIT_L(0); PG8_MMA(0, 0, At, B0); PG8_BAR; PG8_SCHED;
            PG8_LDB(B1, 0, 1); PG8_STAGE(PG8_SB(0, 0), b2, Rb2, ldB2);
            PG8_BAR; PG8_WAIT_L(0); PG8_MMA(0, 1, At, B1); PG8_BAR;
            PG8_LDA(At, 0, 1); PG8_STAGE(PG8_SA(0, 0), a2, R2, ldA2);
            PG8_BAR; PG8_WAIT_L(0); PG8_MMA(1, 0, At, B0); PG8_BAR; PG8_SCHED;
            PG8_STAGE(PG8_SB(0, 1), b2 + hB2, Rb2, ldB2);
            PG8_WAIT_V(6); PG8_BAR; PG8_MMA(1, 1, At, B1); PG8_BAR;
            PG8_LDB(B0, 1, 0); PG8_SCHED; PG8_LDA(At, 1, 0); PG8_STAGE(PG8_SA(0, 1), a2 + hA2, R2, ldA2);
            PG8_WAIT_L(8); PG8_BAR; PG8_WAIT_L(0); PG8_MMA(0, 0, At, B0); PG8_BAR; PG8_SCHED;
            PG8_LDB(B1, 1, 1); PG8_STAGE(PG8_SB(1, 0), b3, Rb2, ldB2);
            PG8_BAR; PG8_WAIT_L(0); PG8_MMA(0, 1, At, B1); PG8_BAR;
            PG8_LDA(At, 1, 1); PG8_STAGE(PG8_SA(1, 0), a3, R2, ldA2);
            PG8_BAR; PG8_WAIT_L(0); PG8_MMA(1, 0, At, B0); PG8_BAR; PG8_SCHED;
            PG8_STAGE(PG8_SB(1, 1), b3 + hB2, Rb2, ldB2);
            PG8_WAIT_V(6); PG8_BAR; PG8_MMA(1, 1, At, B1); PG8_BAR;
        }
        E(acc, cur, st, wr, wc, fr, fq);
        if (!has_next) break;
#pragma unroll
        for (int a = 0; a < 2; ++a)
#pragma unroll
            for (int b = 0; b < 2; ++b)
#pragma unroll
                for (int m = 0; m < 4; ++m)
#pragma unroll
                    for (int n = 0; n < 2; ++n) acc[a][b][m][n] = (f32x4){0.f, 0.f, 0.f, 0.f};
        cur = nxt; cA = nA; cB = nB; if (sn == 0) ++ti; st = sn;
    }
    PG8_WAIT_V(0);
    if (wr == 0) PG8_BAR;
    PG8_BAR;
#undef PG8_SA
#undef PG8_SB
#undef PG8_STAGE
#undef PG8_LDA
#undef PG8_LDB
#undef PG8_MMA
#undef PG8_WAIT_V
#undef PG8_WAIT_L
#undef PG8_BAR
#undef PG8_SCHED
}
template <class Epi, class Sched>
DEVI void gemm_phase_gather(char* lds_generic, const Gemm g, const Sched& S, const Epi& E) {
    PG8_LAS unsigned char* lds = (PG8_LAS unsigned char*)lds_generic;
    const int tid = tidx(), wid = __builtin_amdgcn_readfirstlane(tid >> 6), lane = tid & 63, wr = wid >> 2, wc = wid & 3, fr = lane & 15, fq = lane >> 4;
    const int K = g.K, nt = K / BK;
    unsigned voffB[2];
#pragma unroll
    for (int i = 0; i < 2; ++i) { int R, C; stage_rc(tid * 16 + i * 8192, R, C); const int Rb = Epi::PERM ? ((R & ~31) + perm32(R & 31)) : R;
        voffB[i] = (unsigned)(Rb * K + C) * 2u; }
    unsigned pa[2][2], pn[2][2];
#define PG8_ROWS(P, u) do { int kk_, sb_, nn_; S.unit_rows(u, kk_, sb_, nn_); const int t16_ = tidx() * 16; _Pragma("unroll") for (int i_ = 0; i_ < 2; ++i_) { int R_, C_; stage_rc(t16_ + i_ * 8192, R_, C_); \
        _Pragma("unroll") for (int h_ = 0; h_ < 2; ++h_) P[h_][i_] = S.row_off(kk_, sb_ + h_ * HALF + R_, nn_) + (unsigned)(C_ * 2); } } while (0)
#define PG8_STAGE_AG(bufoff, P, h, koff) do { _Pragma("unroll") for (int _i = 0; _i < 2; ++_i) \
        __builtin_amdgcn_global_load_lds((const unsigned*)((const char*)g.A + (size_t)P[h][_i] + (koff)), (PG8_LAS unsigned*)(lds + (bufoff) + ldsw + _i * 8192), 16, 0, 0); } while (0)
    const size_t kstep = (size_t)(BK * 2);
    const size_t hstep = (size_t)HALF * K * 2;
    const size_t tstep = 2 * hstep;
    const unsigned ldsw = (unsigned)wid * 1024u;
    const int aoff = lds_byte(wr * 64 + fr, fq * 8), boff = lds_byte(wc * 32 + fr, fq * 8);
#define PG8_SA(b, h) (((b) * 2 + (h)) * HTB)
#define PG8_SB(b, h) ((4 + (b) * 2 + (h)) * HTB)
#define PG8_STAGE(bufoff, gbase, voff) do { _Pragma("unroll") for (int _i = 0; _i < 2; ++_i) \
        __builtin_amdgcn_global_load_lds((const unsigned*)((const char*)(gbase) + (voff)[_i]), (PG8_LAS unsigned*)(lds + (bufoff) + ldsw + _i * 8192), 16, 0, 0); } while (0)
#define PG8_LDA(dst, b, h) do { _Pragma("unroll") for (int m = 0; m < 4; ++m) _Pragma("unroll") for (int k = 0; k < 2; ++k) dst[m][k] = *(const PG8_LAS bf16x8*)(lds + PG8_SA(b, h) + aoff + m * 2048 + k * 1024); } while (0)
#define PG8_LDB(dst, b, h) do { _Pragma("unroll") for (int n = 0; n < 2; ++n) _Pragma("unroll") for (int k = 0; k < 2; ++k) dst[n][k] = *(const PG8_LAS bf16x8*)(lds + PG8_SB(b, h) + boff + n * 2048 + k * 1024); } while (0)
#define PG8_MMA(ai, bj, At, Bt) do { __builtin_amdgcn_s_setprio(1); _Pragma("unroll") for (int m = 0; m < 4; ++m) _Pragma("unroll") for (int n = 0; n < 2; ++n) _Pragma("unroll") for (int k = 0; k < 2; ++k) \
        acc[ai][bj][m][n] = __builtin_amdgcn_mfma_f32_16x16x32_bf16(Bt[n][k], At[m][k], acc[ai][bj][m][n], 0, 0, 0); __builtin_amdgcn_s_setprio(0); } while (0)
#define PG8_WAIT_V(n) asm volatile("s_waitcnt vmcnt(" #n ")" ::: "memory")
#define PG8_WAIT_L(n) asm volatile("s_waitcnt lgkmcnt(" #n ")" ::: "memory")
#define PG8_BAR __builtin_amdgcn_s_barrier()
#define PG8_SCHED __builtin_amdgcn_sched_barrier(0)
    __syncthreads();
    Unit cur, nxt; int ui = 0;
    if (!S.next(0, cur)) return;
    f32x4 acc[2][2][4][2];
#pragma unroll
    for (int a = 0; a < 2; ++a)
#pragma unroll
        for (int b = 0; b < 2; ++b)
#pragma unroll
            for (int m = 0; m < 4; ++m)
#pragma unroll
                for (int n = 0; n < 2; ++n) acc[a][b][m][n] = (f32x4){0.f, 0.f, 0.f, 0.f};
    bf16x8 At[4][2], B0[2][2], B1[2][2];
    const char* cB = (const char*)g.Bt + (size_t)cur.pn * tstep;
    PG8_ROWS(pa, cur);
    PG8_STAGE(PG8_SB(0, 0), cB, voffB); PG8_STAGE_AG(PG8_SA(0, 0), pa, 0, 0); PG8_STAGE(PG8_SB(0, 1), cB + hstep, voffB); PG8_STAGE_AG(PG8_SA(0, 1), pa, 1, 0);
    if (wr == 1) PG8_BAR;
    PG8_WAIT_V(4); PG8_BAR;
    PG8_STAGE(PG8_SB(1, 0), cB + kstep, voffB); PG8_STAGE_AG(PG8_SA(1, 0), pa, 0, kstep); PG8_STAGE(PG8_SB(1, 1), cB + hstep + kstep, voffB);
    PG8_WAIT_V(6); PG8_BAR;
    for (;;) {
        const bool has_next = S.next(ui + 1, nxt);
        const char* nB = has_next ? (const char*)g.Bt + (size_t)nxt.pn * tstep : cB;
        if (has_next) PG8_ROWS(pn, nxt);
        else { _Pragma("unroll") for (int h_ = 0; h_ < 2; ++h_) _Pragma("unroll") for (int i_ = 0; i_ < 2; ++i_) pn[h_][i_] = pa[h_][i_]; }
        for (int t = 0; t < nt; t += 2) {
            const bool last = (t == nt - 2);
            const size_t k1 = (size_t)(t + 1) * kstep, k2 = (size_t)(t + 2) * kstep, k3 = (size_t)(t + 3) * kstep;
            const char* b2 = last ? nB : cB + k2;
            const char* b3 = b2 + kstep;
            PG8_LDB(B0, 0, 0); PG8_SCHED; PG8_LDA(At, 0, 0); PG8_STAGE_AG(PG8_SA(1, 1), pa, 1, k1);
            PG8_WAIT_L(8); PG8_BAR; PG8_WAIT_L(0); PG8_MMA(0, 0, At, B0); PG8_BAR; PG8_SCHED;
            PG8_LDB(B1, 0, 1); PG8_STAGE(PG8_SB(0, 0), b2, voffB);
            PG8_BAR; PG8_WAIT_L(0); PG8_MMA(0, 1, At, B1); PG8_BAR;
            PG8_LDA(At, 0, 1); if (last) PG8_STAGE_AG(PG8_SA(0, 0), pn, 0, 0); else PG8_STAGE_AG(PG8_SA(0, 0), pa, 0, k2);
            PG8_BAR; PG8_WAIT_L(0); PG8_MMA(1, 0, At, B0); PG8_BAR; PG8_SCHED;
            PG8_STAGE(PG8_SB(0, 1), b2 + hstep, voffB);
            PG8_WAIT_V(6); PG8_BAR; PG8_MMA(1, 1, At, B1); PG8_BAR;
            PG8_LDB(B0, 1, 0); PG8_SCHED; PG8_LDA(At, 1, 0); if (last) PG8_STAGE_AG(PG8_SA(0, 1), pn, 1, 0); else PG8_STAGE_AG(PG8_SA(0, 1), pa, 1, k2);
            PG8_WAIT_L(8); PG8_BAR; PG8_WAIT_L(0); PG8_MMA(0, 0, At, B0); PG8_BAR; PG8_SCHED;
            PG8_LDB(B1, 1, 1); PG8_STAGE(PG8_SB(1, 0), b3, voffB);
            PG8_BAR; PG8_WAIT_L(0); PG8_MMA(0, 1, At, B1); PG8_BAR;
            PG8_LDA(At, 1, 1); if (last) PG8_STAGE_AG(PG8_SA(1, 0), pn, 0, kstep); else PG8_STAGE_AG(PG8_SA(1, 0), pa, 0, k3);
            PG8_BAR; PG8_WAIT_L(0); PG8_MMA(1, 0, At, B0); PG8_BAR; PG8_SCHED;
            PG8_STAGE(PG8_SB(1, 1), b3 + hstep, voffB);
            PG8_WAIT_V(6); PG8_BAR; PG8_MMA(1, 1, At, B1); PG8_BAR;
        }
        E(acc, cur, wr, wc, fr, fq); S.done(cur);
        if (!has_next) break;
#pragma unroll
        for (int a = 0; a < 2; ++a)
#pragma unroll
            for (int b = 0; b < 2; ++b)
#pragma unroll
                for (int m = 0; m < 4; ++m)
#pragma unroll
                    for (int n = 0; n < 2; ++n) acc[a][b][m][n] = (f32x4){0.f, 0.f, 0.f, 0.f};
        cur = nxt; cB = nB; ++ui;
        _Pragma("unroll") for (int h_ = 0; h_ < 2; ++h_) _Pragma("unroll") for (int i_ = 0; i_ < 2; ++i_) pa[h_][i_] = pn[h_][i_];
    }
    PG8_WAIT_V(0);
    if (wr == 0) PG8_BAR;
    PG8_BAR;
#undef PG8_SA
#undef PG8_ROWS
#undef PG8_STAGE_AG
#undef PG8_SB
#undef PG8_STAGE
#undef PG8_LDA
#undef PG8_LDB
#undef PG8_MMA
#undef PG8_WAIT_V
#undef PG8_WAIT_L
#undef PG8_BAR
#undef PG8_SCHED
}
struct EpiStoreBf16 {
    static constexpr bool PERM = true;
    bf16_t* O; int ld;
    DEVI void operator()(const f32x4 (&acc)[2][2][4][2], const Unit& u, int wr, int wc, int fr, int fq) const {
        const int row0 = u.pm * BM + wr * 64 + fr, col0 = u.pn * BM + wc * 32 + 8 * fq;
#pragma unroll
        for (int ai = 0; ai < 2; ++ai)
#pragma unroll
            for (int m = 0; m < 4; ++m) { bf16_t* rowp = O + (size_t)(row0 + ai * HALF + m * 16) * ld + col0;
#pragma unroll
                for (int bj = 0; bj < 2; ++bj) { const u32x4 w = {pk2(acc[ai][bj][m][0][0], acc[ai][bj][m][0][1]), pk2(acc[ai][bj][m][0][2], acc[ai][bj][m][0][3]),
                                                                 pk2(acc[ai][bj][m][1][0], acc[ai][bj][m][1][1]), pk2(acc[ai][bj][m][1][2], acc[ai][bj][m][1][3])};
                    *(u32x4*)(rowp + bj * HALF) = w; } }
    }
};
template <bool F32IN> struct EpiResid {
    static constexpr bool PERM = true;
    const float* xf; bf16_t* xb; float* part;
    mutable float ssqa[2][4];
    DEVI void operator()(const f32x4 (&acc)[2][2][4][2], const Unit& u, int wr, int wc, int fr, int fq) const {
        const int row0 = u.pm * BM + wr * 64 + fr, col0 = u.pn * BM + wc * 32 + 8 * fq, lane = fr | (fq << 4);
#pragma unroll
        for (int ai = 0; ai < 2; ++ai) {
            float xin[4][2][8];
#pragma unroll
            for (int m = 0; m < 4; ++m)
#pragma unroll
                for (int bj = 0; bj < 2; ++bj) {
                    const int row = row0 + ai * HALF + m * 16, col = col0 + bj * HALF;
                    if (F32IN) { const f32x4 a = *(const f32x4*)(xf + (size_t)row * DM + col), b = *(const f32x4*)(xf + (size_t)row * DM + col + 4);
#pragma unroll
                        for (int e = 0; e < 4; ++e) { xin[m][bj][e] = a[e]; xin[m][bj][4 + e] = b[e]; } }
                    else unpack8(*(const bf16x8*)(xb + (size_t)row * XLD + col), xin[m][bj]);
                }
#pragma unroll
            for (int m = 0; m < 4; ++m) {
                const int row = row0 + ai * HALF + m * 16;
                float ssq = 0.f;
#pragma unroll
                for (int bj = 0; bj < 2; ++bj) {
                    const int col = col0 + bj * HALF;
                    float o[8];
#pragma unroll
                    for (int e = 0; e < 4; ++e) { o[e] = xin[m][bj][e] + acc[ai][bj][m][0][e]; o[4 + e] = xin[m][bj][4 + e] + acc[ai][bj][m][1][e]; }
#pragma unroll
                    for (int e = 0; e < 8; ++e) ssq += o[e] * o[e];
                    *(bf16x8*)(xb + (size_t)row * XLD + col) = pack8(o);
                }
                ssq += ssqa[ai][m];
                if (u.pn == 3) {
                    ssq += __int_as_float(__builtin_amdgcn_ds_bpermute((lane ^ 16) << 2, __float_as_int(ssq)));
                    ssq += __int_as_float(__builtin_amdgcn_ds_bpermute((lane ^ 32) << 2, __float_as_int(ssq)));
                    if (fq == 0) part[(size_t)row * 4 + wc] = ssq;
                    ssq = 0.f;
                }
                ssqa[ai][m] = ssq;
            }
        }
    }
};
struct EpiStoreScaled {
    static constexpr bool PERM = true;
    bf16_t* O; int ld; const float* rss;
    DEVI void operator()(const f32x4 (&acc)[2][2][4][2], const Unit& u, int wr, int wc, int fr, int fq) const {
        const int row0 = u.pm * BM + wr * 64 + fr, col0 = u.pn * BM + wc * 32 + 8 * fq;
#pragma unroll
        for (int ai = 0; ai < 2; ++ai)
#pragma unroll
            for (int m = 0; m < 4; ++m) { const int row = row0 + ai * HALF + m * 16;
                const f32x4 pv = *(const f32x4*)(rss + (size_t)row * 4); const float r = rsqrtf((pv[0] + pv[1] + pv[2] + pv[3]) * (1.f / DM) + EPS);
                bf16_t* rowp = O + (size_t)row * ld + col0;
#pragma unroll
                for (int bj = 0; bj < 2; ++bj) { const f32x4 a = acc[ai][bj][m][0] * r, b = acc[ai][bj][m][1] * r;
                    const u32x4 w = {pk2(a[0], a[1]), pk2(a[2], a[3]), pk2(b[0], b[1]), pk2(b[2], b[3])};
                    *(u32x4*)(rowp + bj * HALF) = w; } }
    }
};
}

DEVI void rmsnorm_to_bf16(const float* src, const float* gain, bf16_t* dst, int nrows) {
    const int lane = tidx() & 63, wid = tidx() >> 6;
    const f32x4* g4 = (const f32x4*)gain;
    f32x4 g[4];
#pragma unroll
    for (int j = 0; j < 4; ++j) g[j] = g4[lane + 64 * j];
    for (int row0 = (bidx() * 8 + wid) * 2; row0 < nrows; row0 += gdim() * 16) {
        f32x4 v[2][4];
#pragma unroll
        for (int rr = 0; rr < 2; ++rr) { const f32x4* s = (const f32x4*)(src + (size_t)(row0 + rr) * DM);
#pragma unroll
            for (int j = 0; j < 4; ++j) v[rr][j] = s[lane + 64 * j]; }
#pragma unroll
        for (int rr = 0; rr < 2; ++rr) {
            float ss = 0.f;
#pragma unroll
            for (int j = 0; j < 4; ++j) ss += v[rr][j][0] * v[rr][j][0] + v[rr][j][1] * v[rr][j][1] + v[rr][j][2] * v[rr][j][2] + v[rr][j][3] * v[rr][j][3];
            ss = wave_sum(ss);
            const float r = rsqrtf(ss * (1.f / DM) + EPS);
#pragma unroll
            for (int j = 0; j < 4; ++j) *(u32x2*)(dst + (size_t)(row0 + rr) * DM + (lane + 64 * j) * 4) = pack4(v[rr][j] * r * g[j]);
        }
    }
}

template <class SF>
DEVI void convT(bf16_t* dst, int N, int K, SF sf, char* lds) {
    bf16_t* tile = (bf16_t*)lds;
    const int tid = tidx();
    const int ntk = K >> 6, ntiles = (N >> 7) * ntk;
    const int nn = tid & 63, kk0 = tid >> 6, on = tid >> 3, kc = (tid & 7) * 8;
    float va[16], vb[16];
#define CT_LOAD(V, t_) do { const int n0_ = ((t_) / ntk) << 7, k0_ = ((t_) % ntk) << 6; _Pragma("unroll") for (int h = 0; h < 2; ++h) _Pragma("unroll") for (int i = 0; i < 8; ++i) V[h * 8 + i] = sf(k0_ + kk0 + 8 * i, n0_ + 64 * h + nn); } while (0)
#define CT_EMIT(V, t_) do { const int n0_ = ((t_) / ntk) << 7, k0_ = ((t_) % ntk) << 6;                                  \
        __syncthreads();                                                                                                 \
        _Pragma("unroll") for (int h = 0; h < 2; ++h) _Pragma("unroll") for (int i = 0; i < 8; ++i) tile[h * (64 * 66) + (kk0 + 8 * i) * 66 + nn] = f2bf(V[h * 8 + i]); \
        __syncthreads();                                                                                                 \
        _Pragma("unroll") for (int h = 0; h < 2; ++h) { u32x4 w;                                                         \
        _Pragma("unroll") for (int e = 0; e < 4; ++e) w[e] = (unsigned)tile[h * (64 * 66) + (kc + 2 * e) * 66 + on] | ((unsigned)tile[h * (64 * 66) + (kc + 2 * e + 1) * 66 + on] << 16); \
        *(u32x4*)(dst + (size_t)(n0_ + 64 * h + on) * K + k0_ + kc) = w; } } while (0)
    const int G_ = gdim();
    int t = bidx();
    if (t < ntiles) CT_LOAD(va, t);
    for (; t < ntiles; t += 2 * G_) {
        if (t + G_ < ntiles) CT_LOAD(vb, t + G_);
        CT_EMIT(va, t);
        if (t + G_ < ntiles) {
            if (t + 2 * G_ < ntiles) CT_LOAD(va, t + 2 * G_);
            CT_EMIT(vb, t + G_);
        }
    }
#undef CT_LOAD
#undef CT_EMIT
}

DEVI void phase_prologue(const Params& p, int, char*) {
    const int gt = bidx() * NTHR + tidx(), gn = gdim() * NTHR;
    if (gt < 128) WSP(unsigned, OFF_CNT)[gt] = 0u;
    if (gt < 32) WSB(OFF_ONES)[gt] = gt == 0 ? (bf16_t)0x3F80 : (bf16_t)0;
    const int* pos = G((const int*)p.in[I_POS]);
    float* rc = WSF(OFF_ROPE_C); float* rs = WSF(OFF_ROPE_S);
    for (int i = gt; i < T_ * 16; i += gn) {
        const int t = i >> 4, j = i & 15;
        const float inv = 1.0f / powf(10000.0f, (float)(2 * j) / 32.0f);
        const float ang = (float)pos[t] * inv;
        rc[i] = cosf(ang); rs[i] = sinf(ang);
    }
    rmsnorm_to_bf16(INF(I_MEM), INF(I_MEMNORM), WSB(OFF_MEMN), NBATCH * 256);
}

DEVI void phase_weights(const Params& p, int l, char* lds) {
    const float* w_in = INF(I_WIN) + (size_t)l * DM * NIN;
    convT(WW(W_P), 4352, 1024, [&](int k, int n) { const int c = n < 2592 ? n : (n < 2816 ? -1 : n - 224); return c < 0 ? 0.f : w_in[(size_t)k * NIN + c]; }, lds);
    convT(WW(W_G), 4096, 1024, [&](int k, int n) { return w_in[(size_t)k * NIN + 4128 + n]; }, lds);
    { const float* s = INF(I_WOUTA) + (size_t)l * 512 * 1024; convT(WW(W_OA), 1024, 512, [&](int k, int n) { return s[(size_t)k * 1024 + n]; }, lds); }
    { const float* s = INF(I_S5GLU) + (size_t)l * 512 * 2048;
      convT(WW(W_GLU), 2048, 512, [&](int k, int n) { const int c = ((n >> 2) & 1) * 1024 + (n >> 8) * 128 + ((n >> 5) & 3) * 32 + ((n >> 3) & 3) * 8 + ((n >> 7) & 1) * 4 + (n & 3);
                                                      return s[(size_t)k * 2048 + c]; }, lds); }
    { const float* s = INF(I_WQB) + (size_t)l * 256 * 768; convT(WW(W_QB), 768, 256, [&](int k, int n) { return s[(size_t)k * 768 + n] * MLA_C; }, lds); }
    { const float* s = INF(I_WKVB) + (size_t)l * 256 * 1024; convT(WW(W_KVB), 1024, 256, [&](int k, int n) { return s[(size_t)k * 1024 + n]; }, lds); }
    { const float* s = INF(I_MLAWO) + (size_t)l * 512 * 1024; convT(WW(W_MO), 1024, 512, [&](int k, int n) { return s[(size_t)k * 1024 + n]; }, lds); }
    { const float* s = INF(I_HYWOUT) + (size_t)l * 512 * 1024; convT(WW(W_HO), 1024, 512, [&](int k, int n) { return s[(size_t)k * 1024 + n]; }, lds); }
    { const float* s = INF(I_WMIX) + (size_t)l * 1024 * 1024; convT(WW(W_MIX), 1024, 1024, [&](int k, int n) { return s[(size_t)k * 1024 + n]; }, lds); }
    { const float* s = INF(I_XAWQ) + (size_t)l * 1024 * 512; const float* gx = INF(I_XANORM) + l * DM; convT(WW(W_XQ), 512, 1024, [&](int k, int n) { return s[(size_t)k * 512 + n] * gx[k]; }, lds); }
    { const float* s = INF(I_XAWKV) + (size_t)l * 1024 * 1024; convT(WW(W_XKV), 1024, 1024, [&](int k, int n) { return s[(size_t)k * 1024 + n]; }, lds); }
    { const float* s = INF(I_XAWO) + (size_t)l * 512 * 1024; convT(WW(W_XO), 1024, 512, [&](int k, int n) { return s[(size_t)k * 1024 + n]; }, lds); }
    { const float* sg = INF(I_MOEWG) + (size_t)l * 1024 * 4; const float* se = INF(I_MOEWE) + (size_t)l * 1024 * 32;
      const float* gm = INF(I_MOENORM) + l * DM;
      convT(WW(W_RT), 256, 1024, [&](int k, int n) { return (n < 4 ? sg[k * 4 + n] : (n < 36 ? se[k * 32 + (n - 4)] : 0.f)) * gm[k]; }, lds); }
    { const float* sg = INF(I_MOEGATE) + (size_t)l * 32 * 1024 * 256; const float* su = INF(I_MOEUP) + (size_t)l * 32 * 1024 * 256;
      convT(WW(W_GU), 32 * 512, 1024, [&](int k, int nn) { const int e = nn >> 9, n = nn & 511; const int col = (n >> 5) * 16 + (n & 15);
          const float* s = ((n >> 4) & 1) ? su : sg; return s[((size_t)e * 1024 + k) * 256 + col] * INF(I_MOENORM)[l * DM + k]; }, lds); }
    { const float* sd = INF(I_MOEDOWN) + (size_t)l * 32 * 256 * 1024;
      convT(WW(W_D), 32 * 1024, 256, [&](int k, int nn) { const int e = nn >> 10, n = nn & 1023; return sd[((size_t)e * 256 + k) * 1024 + n]; }, lds); }
    {
        float* zs = (float*)lds;
        float* h1s = (float*)lds + 8 * 36;
        const float* w1 = INF(I_HYW1) + l * 33 * 64; const float* b1 = INF(I_HYB1) + l * 64;
        const float* w2 = INF(I_HYW2) + l * 64 * 64; const float* b2 = INF(I_HYB2) + l * 64;
        const float* fr = INF(I_HYFREQ) + l * 64;
        float* h2 = WSF(OFF_H2);
        const int tl = tidx() >> 6, j = tidx() & 63;
        float w1r[33], w2r[64];
#pragma unroll
        for (int i = 0; i < 33; ++i) w1r[i] = w1[i * 64 + j];
#pragma unroll
        for (int i = 0; i < 64; ++i) w2r[i] = w2[i * 64 + j];
        const float b1j = b1[j], b2j = b2[j], frj = fr[j];
        for (int u = bidx(); u < SEQ / 8; u += gdim()) {
            const int t = u * 8 + tl;
            __syncthreads();
            if (j < 33) {
                float z;
                if (j == 0) z = (float)t / (float)(SEQ - 1);
                else {
                    const int bi = (j - 1) & 15;
                    const float band = 1e-4f + (float)bi * ((15.0f - 1e-4f) / 15.0f);
                    const float ang = (6.283185307179586f / (float)SEQ) * (float)t * band;
                    z = (j <= 16) ? cosf(ang) : -sinf(ang);
                }
                zs[tl * 36 + j] = z;
            }
            __syncthreads();
            float a = b1j;
#pragma unroll
            for (int i = 0; i < 33; ++i) a += zs[tl * 36 + i] * w1r[i];
            h1s[tl * 64 + j] = sinf(frj * a);
            __syncthreads();
            float c = b2j;
#pragma unroll
            for (int i = 0; i < 64; ++i) c += h1s[tl * 64 + i] * w2r[i];
            h2[t * 64 + j] = sinf(frj * c);
        }
    }
}

template <bool FINAL>
DEVI void moe_combine_norm(const Params& p, const float* gain, bf16_t* dst) {
    const int lane = tidx() & 63, wid = tidx() >> 6;
    const f32x4* g4 = (const f32x4*)gain;
    const bf16_t* YD = WSB(OFF_YD); const int* RI = WSP(const int, OFF_ROWIDX);
    bf16_t* xb = XB; float* outp = OUTP;
    for (int row = bidx() * 8 + wid; row < T_; row += gdim() * 8) {
        const u32x2* xs = (const u32x2*)(xb + (size_t)row * XLD);
        const u32x2* y0 = (const u32x2*)(YD + (size_t)RI[row] * DM); const u32x2* y1 = (const u32x2*)(YD + (size_t)RI[T_ + row] * DM);
        f32x4 v[4]; float ss = 0.f;
#pragma unroll
        for (int j = 0; j < 4; ++j) {
            const u32x2 x = xs[lane + 64 * j], a = y0[lane + 64 * j], b = y1[lane + 64 * j];
            v[j] = (f32x4){bflo(x[0]) + bflo(a[0]) + bflo(b[0]), bfhi(x[0]) + bfhi(a[0]) + bfhi(b[0]), bflo(x[1]) + bflo(a[1]) + bflo(b[1]), bfhi(x[1]) + bfhi(a[1]) + bfhi(b[1])};
            ss += v[j][0] * v[j][0] + v[j][1] * v[j][1] + v[j][2] * v[j][2] + v[j][3] * v[j][3];
        }
        ss = wave_sum(ss);
        const float r = rsqrtf(ss * (1.f / DM) + EPS);
#pragma unroll
        for (int j = 0; j < 4; ++j) {
            const f32x4 o = v[j] * r * g4[lane + 64 * j];
            if (FINAL) ((f32x4*)(outp + (size_t)row * DM))[lane + 64 * j] = o;
            else { *(u32x2*)(xb + (size_t)row * XLD + (lane + 64 * j) * 4) = pack4(v[j]); *(u32x2*)(dst + (size_t)row * DM + (lane + 64 * j) * 4) = pack4(o); }
        }
    }
}

DEVI void phase_hy_filter(const Params& p, int l, char* lds) {
    const int tid = tidx(), lane = tid & 63, wid = tid >> 6;
    float* w3s = (float*)lds;
    float* red = (float*)lds + 512;
    const float* w3 = INF(I_HYW3) + (size_t)l * 64 * 2048;
    const float* h2 = WSF(OFF_H2);
    bf16_t* R = WSB(OFF_RTAB);
    const float mind = logf(0.01f) / 1.5f, maxd = logf(0.01f) / 0.3f;
    for (int ug = bidx(); ug < 256; ug += gdim()) {
        const int u0 = ug * 4, o = u0 >> 9, c0 = u0 & 511;
        __syncthreads();
        { const int j = tid >> 7, d = (tid >> 6) & 1, i = tid & 63; w3s[tid] = w3[i * 2048 + o * 1024 + d * 512 + c0 + j]; }
        __syncthreads();
        float delta[4];
#pragma unroll
        for (int j = 0; j < 4; ++j) delta[j] = fabsf(mind + (float)(c0 + j) * ((maxd - mind) / 511.0f));
        float fw[4][8], bw[4][8], ss[4] = {0.f, 0.f, 0.f, 0.f};
#pragma unroll
        for (int r = 0; r < 8; ++r) {
            const int t = tid + 512 * r;
            const f32x4* hr = (const f32x4*)(h2 + t * 64);
            float a[4][2];
#pragma unroll
            for (int j = 0; j < 4; ++j) { a[j][0] = 0.f; a[j][1] = 0.f; }
#pragma unroll 2
            for (int q = 0; q < 16; ++q) {
                const f32x4 hv = hr[q];
#pragma unroll
                for (int j = 0; j < 4; ++j)
#pragma unroll
                    for (int d = 0; d < 2; ++d) { const f32x4 wv = *(const f32x4*)(w3s + (j * 2 + d) * 64 + 4 * q);
                        a[j][d] += hv[0] * wv[0] + hv[1] * wv[1] + hv[2] * wv[2] + hv[3] * wv[3]; }
            }
            const float tn = (float)t / (float)(SEQ - 1);
#pragma unroll
            for (int j = 0; j < 4; ++j) {
                const float dec = expf(-tn * delta[j]);
                const float x = a[j][0] * dec, y = a[j][1] * dec; fw[j][r] = x; bw[j][r] = y;
                ss[j] += x * x + (t >= 1 ? y * y : 0.f);
            }
        }
#pragma unroll
        for (int j = 0; j < 4; ++j) { ss[j] = wave_sum(ss[j]); if (lane == 0) red[wid * 4 + j] = ss[j]; }
        __syncthreads();
#pragma unroll
        for (int j = 0; j < 4; ++j) {
            float tot = 0.f;
#pragma unroll
            for (int w = 0; w < 8; ++w) tot += red[w * 4 + j];
            const float sc = rsqrtf(tot + EPS);
            bf16_t* Ru = R + (size_t)(u0 + j) * 8192;
#pragma unroll
            for (int r = 0; r < 8; ++r) {
                const int t = tid + 512 * r;
                Ru[4096 - t] = f2bf(fw[j][r] * sc);
                if (t >= 1) Ru[4096 + t] = f2bf(bw[j][r] * sc);
            }
            if (tid == 0) Ru[0] = 0;
        }
    }
}
DEVI void phase_norm_mix(const Params& p, int l, char* lds) {
    if (l == 0) rmsnorm_to_bf16(INF(I_X), INF(I_MIXNORM), WSB(OFF_H), T_);
    else moe_combine_norm<false>(p, INF(I_MIXNORM) + l * DM, WSB(OFF_H));
}
DEVI void rmsnorm_xb(const bf16_t* xb, const float* gain, bf16_t* dst) {
    const int lane = tidx() & 63, wid = tidx() >> 6;
    f32x4 g[4];
#pragma unroll
    for (int j = 0; j < 4; ++j) g[j] = ((const f32x4*)gain)[lane + 64 * j];
    for (int row0 = (bidx() * 8 + wid) * 4; row0 < T_; row0 += gdim() * 32) {
        u32x2 v[4][4];
#pragma unroll
        for (int rr = 0; rr < 4; ++rr)
#pragma unroll
            for (int j = 0; j < 4; ++j) v[rr][j] = *(const u32x2*)(xb + (size_t)(row0 + rr) * XLD + (lane + 64 * j) * 4);
#pragma unroll
        for (int rr = 0; rr < 4; ++rr) {
            f32x4 x[4]; float ss = 0.f;
#pragma unroll
            for (int j = 0; j < 4; ++j) { x[j] = (f32x4){bflo(v[rr][j][0]), bfhi(v[rr][j][0]), bflo(v[rr][j][1]), bfhi(v[rr][j][1])};
                ss += x[j][0] * x[j][0] + x[j][1] * x[j][1] + x[j][2] * x[j][2] + x[j][3] * x[j][3]; }
            ss = wave_sum(ss);
            const float r = rsqrtf(ss * (1.f / DM) + EPS);
#pragma unroll
            for (int j = 0; j < 4; ++j) *(u32x2*)(dst + (size_t)(row0 + rr) * DM + (lane + 64 * j) * 4) = pack4(x[j] * r * g[j]);
        }
    }
}
DEVI void phase_norm_xa(const Params& p, int l, char*) { rmsnorm_xb(XB, INF(I_XANORM) + l * DM, WSB(OFF_H)); }
DEVI void phase_norm_moe(const Params& p, int l, char*) { rmsnorm_xb(XB, INF(I_MOENORM) + l * DM, WSB(OFF_H)); }

struct EpiP {
    static constexpr bool PERM = true;
    bf16_t *pa, *ps, *pm, *ph;
    template <int LD>
    DEVI void store(bf16_t* dst, int cb, const f32x4 (&acc)[2][2][4][2], int pm_, int wr, int wc, int fr, int fq) const {
        bf16_t* base = dst + (size_t)(pm_ * 256 + wr * 64 + fr) * LD + cb + wc * 32 + 8 * fq;
#pragma unroll
        for (int ai = 0; ai < 2; ++ai)
#pragma unroll
            for (int m = 0; m < 4; ++m)
#pragma unroll
                for (int bj = 0; bj < 2; ++bj) {
                    const u32x4 w = {pk2(acc[ai][bj][m][0][0], acc[ai][bj][m][0][1]), pk2(acc[ai][bj][m][0][2], acc[ai][bj][m][0][3]),
                                     pk2(acc[ai][bj][m][1][0], acc[ai][bj][m][1][1]), pk2(acc[ai][bj][m][1][2], acc[ai][bj][m][1][3])};
                    *(u32x4*)(base + (ai * 128 + m * 16) * LD + bj * 128) = w; }
    }
    template <int LD>
    DEVI void store_lo(bf16_t* dst, int cb, const f32x4 (&acc)[2][2][4][2], int pm_, int wr, int fr, int fq) const {
        bf16_t* base = dst + (size_t)(pm_ * 256 + wr * 64 + fr) * LD + cb + 8 * fq;
#pragma unroll
        for (int ai = 0; ai < 2; ++ai)
#pragma unroll
            for (int m = 0; m < 4; ++m) {
                const u32x4 w = {pk2(acc[ai][0][m][0][0], acc[ai][0][m][0][1]), pk2(acc[ai][0][m][0][2], acc[ai][0][m][0][3]),
                                 pk2(acc[ai][0][m][1][0], acc[ai][0][m][1][1]), pk2(acc[ai][0][m][1][2], acc[ai][0][m][1][3])};
                *(u32x4*)(base + (ai * 128 + m * 16) * LD) = w; }
    }
    DEVI void operator()(const f32x4 (&acc)[2][2][4][2], const pg8::Unit& u, int wr, int wc, int fr, int fq) const {
        if (u.pn < 6) store<1536>(pa, u.pn * 256, acc, u.pm, wr, wc, fr, fq);
        else if (u.pn < 8) store<512>(ps, (u.pn - 6) * 256, acc, u.pm, wr, wc, fr, fq);
        else if (u.pn < 10) store<768>(pm, (u.pn - 8) * 256, acc, u.pm, wr, wc, fr, fq);
        else if (u.pn == 10) { if (wc == 0) store_lo<768>(pm, 512, acc, u.pm, wr, fr, fq); }
        else store<1536>(ph, (u.pn - 11) * 256, acc, u.pm, wr, wc, fr, fq);
    }
};
DEVI void phase_pgemm(const Params& p, int l, char* lds) {
    {
        pg8::StaticOrder S; S.init(T_, 4352, gdim(), bidx());
        pg8::gemm_phase(lds, pg8::Gemm{WSB(OFF_H), WW(W_P), T_, 4352, DM}, S, EpiP{WSB(OFF_PA), WSB(OFF_PS), WSB(OFF_PM), WSB(OFF_PH)});
    }
}
DEVI void phase_mixA(const Params& p, int l, char* lds) {
    phase_hy_filter(p, l, lds);
    const bf16_t* PA = WSB(OFF_PA); bf16_t* ZA = WSB(OFF_ZA);
    const float* cw = INF(I_CONVA) + l * 3 * 512;
    const int gt = bidx() * NTHR + tidx(), j0 = (gt & 63) * 8;
    float w0[8], w1[8], w2[8];
#pragma unroll
    for (int e = 0; e < 8; ++e) { w0[e] = cw[j0 + e]; w1[e] = cw[512 + j0 + e]; w2[e] = cw[1024 + j0 + e]; }
    for (int i = gt; i < T_ * 64; i += gdim() * NTHR) {
        const int t = i >> 6, tt = t & (SEQ - 1);
        const bf16_t* row = PA + (size_t)t * 1536;
        const bf16x8 z8 = {0, 0, 0, 0, 0, 0, 0, 0};
        const bool hasp = tt > 0, hasn = tt < SEQ - 1;
        const bf16x8 cp = hasp ? *(const bf16x8*)(row - 1536 + 512 + j0) : z8, xp = hasp ? *(const bf16x8*)(row - 1536 + 1024 + j0) : z8;
        const bf16x8 cc_ = *(const bf16x8*)(row + 512 + j0), xc = *(const bf16x8*)(row + 1024 + j0);
        const bf16x8 cn = hasn ? *(const bf16x8*)(row + 1536 + 512 + j0) : z8, xn = hasn ? *(const bf16x8*)(row + 1536 + 1024 + j0) : z8;
        const bf16x8 bb = *(const bf16x8*)(row + j0);
        float a[8], b[8], c[8], d[8], e_[8], f[8], g_[8], o[8];
        unpack8(cp, a); unpack8(xp, b); unpack8(cc_, c); unpack8(xc, d); unpack8(cn, e_); unpack8(xn, f); unpack8(bb, g_);
#pragma unroll
        for (int e = 0; e < 8; ++e) o[e] = g_[e] * (w0[e] * a[e] * b[e] + w1[e] * c[e] * d[e] + w2[e] * e_[e] * f[e]);
        *(bf16x8*)(ZA + (size_t)t * 512 + j0) = pack8(o);
    }
}

DEVI void phase_mla_prep(const Params& p, int l, char*) {
    const int lane = tidx() & 63, wid = tidx() >> 6;
    const bf16_t* PM = WSB(OFF_PM);
    bf16_t* CQN = WSB(OFF_CQN); bf16_t* CKVN = WSB(OFF_CKVN); bf16_t* KR = WSB(OFF_KR);
    const f32x4 gq = ((const f32x4*)(INF(I_QNORM) + l * 256))[lane], gk = ((const f32x4*)(INF(I_KVNORM) + l * 256))[lane];
    const float* rc = WSF(OFF_ROPE_C); const float* rs = WSF(OFF_ROPE_S);
    for (int t0 = (bidx() * 8 + wid) * 4; t0 < T_; t0 += gdim() * 32) {
        u32x2 av[4], bv[4]; float x1[4], x2[4], cv[4], sv[4];
#pragma unroll
        for (int j = 0; j < 4; ++j) {
            const bf16_t* row = PM + (size_t)(t0 + j) * 768;
            av[j] = *(const u32x2*)(row + lane * 4); bv[j] = *(const u32x2*)(row + 256 + lane * 4);
            if (lane < 16) { x1[j] = bf2f(row[512 + lane]); x2[j] = bf2f(row[528 + lane]); cv[j] = rc[(size_t)(t0 + j) * 16 + lane]; sv[j] = rs[(size_t)(t0 + j) * 16 + lane]; }
        }
#pragma unroll
        for (int j = 0; j < 4; ++j) {
            const int t = t0 + j;
            const u32x2 a = av[j], b = bv[j];
            f32x4 q = {bflo(a[0]), bfhi(a[0]), bflo(a[1]), bfhi(a[1])}, k = {bflo(b[0]), bfhi(b[0]), bflo(b[1]), bfhi(b[1])};
            float sq = q[0] * q[0] + q[1] * q[1] + q[2] * q[2] + q[3] * q[3], sk = k[0] * k[0] + k[1] * k[1] + k[2] * k[2] + k[3] * k[3];
            sq = wave_sum(sq); sk = wave_sum(sk);
            const float rq = rsqrtf(sq * (1.f / 256.f) + EPS), rk = rsqrtf(sk * (1.f / 256.f) + EPS);
            *(u32x2*)(CQN + (size_t)t * 256 + lane * 4) = pack4(q * rq * gq);
            *(u32x2*)(CKVN + (size_t)t * 256 + lane * 4) = pack4(k * rk * gk);
            if (lane < 16) {
                KR[(size_t)t * 32 + lane] = f2bf(x1[j] * cv[j] - x2[j] * sv[j]);
                KR[(size_t)t * 32 + 16 + lane] = f2bf(x1[j] * sv[j] + x2[j] * cv[j]);
            }
        }
    }
}

DEVI void phase_qkv(const Params& p, int, char* lds) {
    { pg8::StaticOrder S; S.init(T_, 768, gdim(), bidx());
      pg8::gemm_phase(lds, pg8::Gemm{WSB(OFF_CQN), WW(W_QB), T_, 768, 256}, S, pg8::EpiStoreBf16{WSB(OFF_Q), 768}); }
    { pg8::StaticOrder S; S.init(T_, 1024, gdim(), bidx());
      pg8::gemm_phase(lds, pg8::Gemm{WSB(OFF_CKVN), WW(W_KVB), T_, 1024, 256}, S, pg8::EpiStoreBf16{WSB(OFF_KV), 1024}); }
}

#define KSWZ(row, colB) ((row) * 256 + ((colB) ^ (((row) & 15) << 4)))
#define SBAR() __builtin_amdgcn_sched_barrier(0)
constexpr int SHM_V = 64 * 128 * 2, SHM_K = 64 * 128 * 2;
DEVI int crow(int r, int hi) { return (r & 3) + 8 * (r >> 2) + 4 * hi; }
DEVI void partialSM(f32x16& p0, f32x16& p1, float& m_reg, float& mn, float& alpha, const float C, const float thr_raw) {
    float pmax = p0[0];
#pragma unroll
    for (int r = 1; r < 16; ++r) pmax = fmaxf(pmax, p0[r]);
#pragma unroll
    for (int r = 0; r < 16; ++r) pmax = fmaxf(pmax, p1[r]);
    { auto rr = __builtin_amdgcn_permlane32_swap(__float_as_uint(pmax), __float_as_uint(pmax), false, false);
      pmax = fmaxf(__uint_as_float(rr[0]), __uint_as_float(rr[1])); }
    if (__builtin_expect(__all(pmax - m_reg <= thr_raw), 1)) { mn = m_reg; alpha = 1.f; }
    else { mn = fmaxf(m_reg, pmax); alpha = __builtin_amdgcn_exp2f((m_reg - mn) * C); m_reg = mn; }
    const float mnC = -mn * C;
#pragma unroll
    for (int r = 0; r < 16; ++r) p0[r] = fmaf(p0[r], C, mnC);
#pragma unroll
    for (int r = 0; r < 16; ++r) p1[r] = fmaf(p1[r], C, mnC);
#pragma unroll
    for (int r = 0; r < 16; ++r) p0[r] = __builtin_amdgcn_exp2f(p0[r]);
}
DEVI void partialSM_shift(f32x16& p0, f32x16& p1, float& moff, float& alpha, bf16x8& qoff, const bool first, const int hi) {
    constexpr float THR2 = 8.f * 1.4426950408889634f;
    float pmax = p0[0];
#pragma unroll
    for (int r = 1; r < 16; ++r) pmax = fmaxf(pmax, p0[r]);
#pragma unroll
    for (int r = 0; r < 16; ++r) pmax = fmaxf(pmax, p1[r]);
    { auto rr = __builtin_amdgcn_permlane32_swap(__float_as_uint(pmax), __float_as_uint(pmax), false, false);
      pmax = fmaxf(__uint_as_float(rr[0]), __uint_as_float(rr[1])); }
    if (__builtin_expect(!first && __all(pmax <= THR2), 1)) { alpha = 1.f; }
    else {
        const float want = moff + (first ? pmax : fmaxf(pmax, 0.f));
        const float mnew = __uint_as_float(pk2(want, 0.f) << 16);
        const float d = mnew - moff; moff = mnew; alpha = __builtin_amdgcn_exp2f(-d);
#pragma unroll
        for (int r = 0; r < 16; ++r) { p0[r] -= d; p1[r] -= d; }
        const unsigned nb = hi == 0 ? ((__float_as_uint(-mnew) >> 16) & 0xffffu) : 0u;
        const u32x4 w = {nb, 0u, 0u, 0u}; qoff = *(const bf16x8*)&w;
    }
#pragma unroll
    for (int r = 0; r < 16; ++r) p0[r] = __builtin_amdgcn_exp2f(p0[r]);
}
DEVI void finishSM(f32x16& p0, f32x16& p1, float alpha, float& l_reg, bf16x8& pa0, bf16x8& pa1, bf16x8& pa2, bf16x8& pa3) {
#pragma unroll
    for (int r = 0; r < 16; ++r) p1[r] = __builtin_amdgcn_exp2f(p1[r]);
    float ps = 0;
#pragma unroll
    for (int r = 0; r < 16; ++r) ps += p0[r];
#pragma unroll
    for (int r = 0; r < 16; ++r) ps += p1[r];
    { auto rr = __builtin_amdgcn_permlane32_swap(__float_as_uint(ps), __float_as_uint(ps), false, false);
      ps = __uint_as_float(rr[0]) + __uint_as_float(rr[1]); }
    l_reg = l_reg * alpha + ps;
#define PK4(P, BASE, OUT) do { unsigned a0 = pk2(P[BASE + 0], P[BASE + 1]), a1 = pk2(P[BASE + 2], P[BASE + 3]);   \
    unsigned b0 = pk2(P[BASE + 4], P[BASE + 5]), b1 = pk2(P[BASE + 6], P[BASE + 7]);                              \
    auto r0 = __builtin_amdgcn_permlane32_swap(a0, b0, false, false); auto r1 = __builtin_amdgcn_permlane32_swap(a1, b1, false, false); \
    u32x4 w = {r0[0], r1[0], r0[1], r1[1]}; OUT = *reinterpret_cast<bf16x8*>(&w); } while (0)
    PK4(p0, 0, pa0); PK4(p0, 8, pa1); PK4(p1, 0, pa2); PK4(p1, 8, pa3);
#undef PK4
}
template <int ND0>
DEVI void qkt(f32x16& p0, f32x16& p1, const bf16_t* Ks, const bf16x8 (&qr)[ND0], int r32, int hi) {
#pragma unroll
    for (int r = 0; r < 16; ++r) { p0[r] = 0.f; p1[r] = 0.f; }
#pragma unroll
    for (int d0 = 0; d0 < ND0; ++d0) {
        const int cb = (d0 * 16 + hi * 8) * 2;
        const bf16x8 b0 = *reinterpret_cast<const bf16x8*>((const char*)Ks + KSWZ(r32, cb));
        const bf16x8 b1 = *reinterpret_cast<const bf16x8*>((const char*)Ks + KSWZ(32 + r32, cb));
        p0 = __builtin_amdgcn_mfma_f32_32x32x16_bf16(b0, qr[d0], p0, 0, 0, 0);
        p1 = __builtin_amdgcn_mfma_f32_32x32x16_bf16(b1, qr[d0], p1, 0, 0, 0);
    }
}
DEVI int v_st(int k, int c) { const int kk = (k & ~0xC) | ((k & 4) << 1) | ((k & 8) >> 1); return ((kk >> 3) * 4 + (c >> 5)) * 512 + ((kk & 7) * 32 + (c & 31)) * 2; }
DEVI int v_rd_base(int lane) { return ((lane & 3) << 3) | (((lane >> 2) & 3) << 6) | (((lane >> 4) & 1) << 5) | (((lane >> 5) & 1) << 8); }
constexpr int v_rd_off(int d0, int ks, int half) { return d0 * 512 + ks * 4096 + half * 2048; }
template <int OFF> DEVI s16x4 tr_read(int vb) {
    s16x4 r; asm volatile("ds_read_b64_tr_b16 %0, %1 offset:%2" : "=&v"(r) : "v"(vb), "i"(OFF) : "memory"); return r;
}
template <int D0> DEVI void pv_one(f32x16& od, int vb, bf16x8 pa0, bf16x8 pa1, bf16x8 pa2, bf16x8 pa3) {
    const s16x4 l0 = tr_read<v_rd_off(D0, 0, 0)>(vb), h0 = tr_read<v_rd_off(D0, 0, 1)>(vb), l1 = tr_read<v_rd_off(D0, 1, 0)>(vb), h1 = tr_read<v_rd_off(D0, 1, 1)>(vb);
    const s16x4 l2 = tr_read<v_rd_off(D0, 2, 0)>(vb), h2 = tr_read<v_rd_off(D0, 2, 1)>(vb), l3 = tr_read<v_rd_off(D0, 3, 0)>(vb), h3 = tr_read<v_rd_off(D0, 3, 1)>(vb);
    asm volatile("s_waitcnt lgkmcnt(0)" ::: "memory"); SBAR();
#define PKV(L, H) (bf16x8){L[0], L[1], L[2], L[3], H[0], H[1], H[2], H[3]}
    od = __builtin_amdgcn_mfma_f32_32x32x16_bf16(pa0, PKV(l0, h0), od, 0, 0, 0);
    od = __builtin_amdgcn_mfma_f32_32x32x16_bf16(pa1, PKV(l1, h1), od, 0, 0, 0);
    od = __builtin_amdgcn_mfma_f32_32x32x16_bf16(pa2, PKV(l2, h2), od, 0, 0, 0);
    od = __builtin_amdgcn_mfma_f32_32x32x16_bf16(pa3, PKV(l3, h3), od, 0, 0, 0);
#undef PKV
}
template <int NDV> DEVI void pv_all(f32x16 (&o)[NDV], int vb, bf16x8 pa0, bf16x8 pa1, bf16x8 pa2, bf16x8 pa3) {
    pv_one<0>(o[0], vb, pa0, pa1, pa2, pa3); pv_one<1>(o[1], vb, pa0, pa1, pa2, pa3);
    if constexpr (NDV == 4) { pv_one<2>(o[2], vb, pa0, pa1, pa2, pa3); pv_one<3>(o[3], vb, pa0, pa1, pa2, pa3); }
}
template <int DQK, int DV, bool SHIFT = false>
DEVI void attn_body(const bf16_t* Qw, const bf16_t* kp, int kstr, bool kact, const bf16_t* vp, int vstr, bool vact,
                    bf16_t* Ow, int ldo, int seq, const float scale, char* lds, const float* qrc = nullptr, const float* qrs = nullptr) {
    constexpr int ND0 = DQK / 16 + (SHIFT ? 1 : 0), NDV = DV / 32;
    const float C = scale * 1.4426950408889634f, thr_raw = 8.f / scale;
    const int tid = tidx(), wid = tid >> 6, lane = tid & 63, r32 = lane & 31, hi = lane >> 5;
    bf16_t* V_lds = (bf16_t*)lds; bf16_t* K_lds = (bf16_t*)(lds + 3 * SHM_V);
    float* wsl = (float*)(lds + 3 * SHM_V + 3 * SHM_K) + wid * 64; float* li_l = wsl; float* al_l = wsl + 32;
    float m_reg = -1e30f, l_reg = 0; f32x16 o[NDV]; bf16x8 qr[ND0];
#pragma unroll
    for (int d = 0; d < NDV; ++d)
#pragma unroll
        for (int r = 0; r < 16; ++r) o[d][r] = 0.f;
#pragma unroll
    for (int d0 = 0; d0 < DQK / 16; ++d0) qr[d0] = *(const bf16x8*)(Qw + d0 * 16);
    if constexpr (SHIFT) qr[ND0 - 1] = (bf16x8){0, 0, 0, 0, 0, 0, 0, 0};
    if constexpr (DQK == 96) {
        if (qrc) {
            float x1[8], x2[8], c[8], sn[8]; unpack8(qr[4], x1); unpack8(qr[5], x2);
            *(f32x4*)&c[0] = *(const f32x4*)qrc; *(f32x4*)&c[4] = *(const f32x4*)(qrc + 4); *(f32x4*)&sn[0] = *(const f32x4*)qrs; *(f32x4*)&sn[4] = *(const f32x4*)(qrs + 4);
            float y1[8], y2[8];
#pragma unroll
            for (int e = 0; e < 8; ++e) { y1[e] = x1[e] * c[e] - x2[e] * sn[e]; y2[e] = x1[e] * sn[e] + x2[e] * c[e]; }
            qr[4] = pack8(y1); qr[5] = pack8(y2);
        }
    }
    const int sr = tid >> 4, sc = (tid & 15) * 8, vst0 = v_st(sr, sc), vst1 = v_st(32 + sr, sc);
    const int vb0 = (int)(uintptr_t)V_lds + v_rd_base(lane);
    bf16x8 vsA0, vsA1, ksA0, ksA1, vsB0, vsB1, ksB0, ksB1;
    vsA0 = vsA1 = ksA0 = ksA1 = vsB0 = vsB1 = ksB0 = ksB1 = (bf16x8){0, 0, 0, 0, 0, 0, 0, 0};
    const int vo0 = vst0, ko0 = 3 * SHM_V + KSWZ(sr, sc * 2);
    static_assert(SHM_V == 16384 && SHM_K == 16384, "staging offsets assume 16 KiB tile images");
    (void)kact; (void)vact;
#define SLOAD(S, k0) do { vs##S##0 = *(const bf16x8*)(vp + (size_t)((k0) + sr) * vstr); vs##S##1 = *(const bf16x8*)(vp + (size_t)((k0) + 32 + sr) * vstr); \
    ks##S##0 = *(const bf16x8*)(kp + (size_t)((k0) + sr) * kstr); ks##S##1 = *(const bf16x8*)(kp + (size_t)((k0) + 32 + sr) * kstr); } while (0)
#define SWRITE(b, S) do { char* base_ = lds + (b) * 16384; *(bf16x8*)(base_ + vo0) = vs##S##0; *(bf16x8*)(base_ + vo0 + 8192) = vs##S##1; \
    *(bf16x8*)(base_ + ko0) = ks##S##0; *(bf16x8*)(base_ + ko0 + 8192) = ks##S##1; } while (0)
#define SWAIT() asm volatile("s_waitcnt vmcnt(4)" ::: "memory")
#define RESC(a) do { if (__any((a) < 1.f)) { if (hi == 0) al_l[r32] = (a); asm volatile("s_waitcnt lgkmcnt(0)" ::: "memory"); \
    _Pragma("unroll") for (int d = 0; d < NDV; ++d) _Pragma("unroll") for (int r = 0; r < 16; ++r) o[d][r] *= al_l[crow(r, hi)]; } } while (0)
    f32x16 pA0, pA1, pB0, pB1; float mnA, mnB, alA, alB; bf16x8 pa0, pa1, pa2, pa3; const int NTL = seq / 64;
    float moff = 0.f;
#define PSM(P0, P1, MN, AL, FIRST) do { if constexpr (SHIFT) partialSM_shift(P0, P1, moff, AL, qr[ND0 - 1], FIRST, hi); else partialSM(P0, P1, m_reg, MN, AL, C, thr_raw); } while (0)
#define KIMG(b) ((bf16_t*)((char*)K_lds + (b) * SHM_K))
#define NXT3(b) ((b) == 2 ? 0 : (b) + 1)
    __syncthreads();
    SLOAD(A, 0); asm volatile("s_waitcnt vmcnt(0)" ::: "memory"); SWRITE(0, A); __syncthreads();
    qkt<ND0>(pA0, pA1, KIMG(0), qr, r32, hi); PSM(pA0, pA1, mnA, alA, true);
    SLOAD(B, 64); SLOAD(A, 128);
    SWAIT(); SWRITE(1, B); __syncthreads();
    int bp = 0, bq = 1, bw = 2;
    for (int j = 1; j + 1 < NTL; j += 2) {
        SBAR(); qkt<ND0>(pB0, pB1, KIMG(bq), qr, r32, hi);
        finishSM(pA0, pA1, alA, l_reg, pa0, pa1, pa2, pa3); SBAR();
        SLOAD(B, (j + 2) * 64); SBAR();
        pv_all<NDV>(o, vb0 + bp * SHM_V, pa0, pa1, pa2, pa3); PSM(pB0, pB1, mnB, alB, false);
        SWAIT(); SWRITE(bw, A);
        RESC(alB); __syncthreads();
        bp = bq; bq = bw; bw = NXT3(bw);
        SBAR(); qkt<ND0>(pA0, pA1, KIMG(bq), qr, r32, hi);
        finishSM(pB0, pB1, alB, l_reg, pa0, pa1, pa2, pa3); SBAR();
        { const int jn = j + 3 < NTL ? j + 3 : NTL - 1; SLOAD(A, jn * 64); } SBAR();
        pv_all<NDV>(o, vb0 + bp * SHM_V, pa0, pa1, pa2, pa3); PSM(pA0, pA1, mnA, alA, false);
        SWAIT(); SWRITE(bw, B);
        RESC(alA); __syncthreads();
        bp = bq; bq = bw; bw = NXT3(bw);
    }
    SBAR(); qkt<ND0>(pB0, pB1, KIMG(bq), qr, r32, hi);
    finishSM(pA0, pA1, alA, l_reg, pa0, pa1, pa2, pa3); SBAR();
    pv_all<NDV>(o, vb0 + bp * SHM_V, pa0, pa1, pa2, pa3); PSM(pB0, pB1, mnB, alB, false);
    RESC(alB);
    finishSM(pB0, pB1, alB, l_reg, pa0, pa1, pa2, pa3); SBAR();
    pv_all<NDV>(o, vb0 + bq * SHM_V, pa0, pa1, pa2, pa3);
#undef KIMG
#undef PSM
#undef NXT3
    if (hi == 0) li_l[r32] = l_reg; asm volatile("s_waitcnt lgkmcnt(0)" ::: "memory");
    float rli[16];
#pragma unroll
    for (int r = 0; r < 16; ++r) rli[r] = __builtin_amdgcn_rcpf(li_l[crow(r, hi)]);
    bf16_t* Owv = Ow + (size_t)(wid * 32) * ldo;
#pragma unroll
    for (int r = 0; r < 16; ++r) { const int orow = crow(r, hi);
#pragma unroll
        for (int d0 = 0; d0 < NDV; ++d0) Owv[(size_t)orow * ldo + d0 * 32 + r32] = f2bf(o[d0][r] * rli[r]); }
#undef SLOAD
#undef SWRITE
#undef SWAIT
#undef RESC
}

template <int OFF> DEVI s16x4 tr_rd(const LAS char* vb) { return __builtin_amdgcn_ds_read_tr16_b64_v4i16((LAS s16x4*)(vb + OFF)); }
template <int ND0, class MID>
DEVI void mphase2(f32x16& p0, f32x16& p1, f32x16 (&o)[2], const LAS char* Ki, const LAS char* vb, const bf16x8 (&qr)[ND0],
                  bf16x8 pa0, bf16x8 pa1, bf16x8 pa2, bf16x8 pa3, int r32, int hi, MID&& mid) {
    static_assert(ND0 >= 5 && ND0 <= 8, "V chunks ride under the last four k-steps");
    bf16x8 kf[ND0][2]; s16x4 vl[2][4], vh[2][4];
#define RK(d) do { const int cb_ = ((d) * 16 + hi * 8) * 2; kf[d][0] = *(const LAS bf16x8*)(Ki + KSWZ(r32, cb_)); kf[d][1] = *(const LAS bf16x8*)(Ki + KSWZ(32 + r32, cb_)); } while (0)
#define RV(c) do { constexpr int d_ = (c) & 1, k_ = ((c) >> 1) * 2; vl[d_][k_] = tr_rd<v_rd_off(d_, k_, 0)>(vb); vh[d_][k_] = tr_rd<v_rd_off(d_, k_, 1)>(vb); \
    vl[d_][k_ + 1] = tr_rd<v_rd_off(d_, k_ + 1, 0)>(vb); vh[d_][k_ + 1] = tr_rd<v_rd_off(d_, k_ + 1, 1)>(vb); } while (0)
    RK(0); RK(1); RK(2); RK(3); SBAR();
#pragma unroll
    for (int r = 0; r < 16; ++r) { p0[r] = 0.f; p1[r] = 0.f; }
#define KS(d) do { p0 = __builtin_amdgcn_mfma_f32_32x32x16_bf16(kf[d][0], qr[d], p0, 0, 0, 0); p1 = __builtin_amdgcn_mfma_f32_32x32x16_bf16(kf[d][1], qr[d], p1, 0, 0, 0); \
    if constexpr ((d) + 4 < ND0) RK(((d) + 4 < ND0 ? (d) + 4 : 0)); else RV(((d) + 4 - ND0) & 3); SBAR(); } while (0)
    KS(0); KS(1); KS(2); KS(3); KS(4);
    if constexpr (ND0 > 5) KS((ND0 > 5 ? 5 : 0));
    if constexpr (ND0 > 6) KS((ND0 > 6 ? 6 : 0));
    if constexpr (ND0 > 7) KS((ND0 > 7 ? 7 : 0));
#undef KS
#undef RK
#undef RV
    mid();
#define PKV(L, H) (bf16x8){L[0], L[1], L[2], L[3], H[0], H[1], H[2], H[3]}
    o[0] = __builtin_amdgcn_mfma_f32_32x32x16_bf16(pa0, PKV(vl[0][0], vh[0][0]), o[0], 0, 0, 0); o[1] = __builtin_amdgcn_mfma_f32_32x32x16_bf16(pa0, PKV(vl[1][0], vh[1][0]), o[1], 0, 0, 0);
    o[0] = __builtin_amdgcn_mfma_f32_32x32x16_bf16(pa1, PKV(vl[0][1], vh[0][1]), o[0], 0, 0, 0); o[1] = __builtin_amdgcn_mfma_f32_32x32x16_bf16(pa1, PKV(vl[1][1], vh[1][1]), o[1], 0, 0, 0);
    o[0] = __builtin_amdgcn_mfma_f32_32x32x16_bf16(pa2, PKV(vl[0][2], vh[0][2]), o[0], 0, 0, 0); o[1] = __builtin_amdgcn_mfma_f32_32x32x16_bf16(pa2, PKV(vl[1][2], vh[1][2]), o[1], 0, 0, 0);
    o[0] = __builtin_amdgcn_mfma_f32_32x32x16_bf16(pa3, PKV(vl[0][3], vh[0][3]), o[0], 0, 0, 0); o[1] = __builtin_amdgcn_mfma_f32_32x32x16_bf16(pa3, PKV(vl[1][3], vh[1][3]), o[1], 0, 0, 0);
#undef PKV
}
template <int DQK, int DV, bool SHIFT = false>
DEVI void attn_body_pp(const bf16_t* Qw, const bf16_t* kp, int kstr, const bf16_t* vp, int vstr,
                       bf16_t* Ow, int ldo, int seq, const float scale, char* lds, const float* qrc = nullptr, const float* qrs = nullptr) {
    constexpr int ND0 = DQK / 16 + (SHIFT ? 1 : 0), NDV = DV / 32;
    const float C = scale * 1.4426950408889634f, thr_raw = 8.f / scale;
    const int tid = tidx(), wid = tid >> 6, lane = tid & 63, r32 = lane & 31, hi = lane >> 5;
    const int g = __builtin_amdgcn_readfirstlane(wid) >> 2;
    bf16_t* V_lds = (bf16_t*)lds; bf16_t* K_lds = (bf16_t*)(lds + 3 * SHM_V);
    float* wsl = (float*)(lds + 3 * SHM_V + 3 * SHM_K) + wid * 64; float* li_l = wsl; float* al_l = wsl + 32;
    float m_reg = -1e30f, l_reg = 0; f32x16 o[NDV]; bf16x8 qr[ND0];
#pragma unroll
    for (int d = 0; d < NDV; ++d)
#pragma unroll
        for (int r = 0; r < 16; ++r) o[d][r] = 0.f;
#pragma unroll
    for (int d0 = 0; d0 < DQK / 16; ++d0) qr[d0] = *(const bf16x8*)(Qw + d0 * 16);
    if constexpr (SHIFT) qr[ND0 - 1] = (bf16x8){0, 0, 0, 0, 0, 0, 0, 0};
    if constexpr (DQK == 96) {
        if (qrc) {
            float x1[8], x2[8], c[8], sn[8]; unpack8(qr[4], x1); unpack8(qr[5], x2);
            *(f32x4*)&c[0] = *(const f32x4*)qrc; *(f32x4*)&c[4] = *(const f32x4*)(qrc + 4); *(f32x4*)&sn[0] = *(const f32x4*)qrs; *(f32x4*)&sn[4] = *(const f32x4*)(qrs + 4);
            float y1[8], y2[8];
#pragma unroll
            for (int e = 0; e < 8; ++e) { y1[e] = x1[e] * c[e] - x2[e] * sn[e]; y2[e] = x1[e] * sn[e] + x2[e] * c[e]; }
            qr[4] = pack8(y1); qr[5] = pack8(y2);
        }
    }
    const int sr = tid >> 4, sc = (tid & 15) * 8, vst0 = v_st(sr, sc);
    const int vb0 = (int)(uintptr_t)V_lds + v_rd_base(lane);
    bf16x8 vsA0, vsA1, ksA0, ksA1, vsB0, vsB1, ksB0, ksB1;
    const int vo0 = vst0, ko0 = 3 * SHM_V + KSWZ(sr, sc * 2);
#define SLOAD(S, k0) do { vs##S##0 = *(const bf16x8*)(vp + (size_t)((k0) + sr) * vstr); vs##S##1 = *(const bf16x8*)(vp + (size_t)((k0) + 32 + sr) * vstr); \
    ks##S##0 = *(const bf16x8*)(kp + (size_t)((k0) + sr) * kstr); ks##S##1 = *(const bf16x8*)(kp + (size_t)((k0) + 32 + sr) * kstr); } while (0)
#define SWRITE(b, S) do { char* base_ = lds + (b) * 16384; *(bf16x8*)(base_ + vo0) = vs##S##0; *(bf16x8*)(base_ + vo0 + 8192) = vs##S##1; \
    *(bf16x8*)(base_ + ko0) = ks##S##0; *(bf16x8*)(base_ + ko0 + 8192) = ks##S##1; } while (0)
#define SWAIT() asm volatile("s_waitcnt vmcnt(4)" ::: "memory")
#define RESC(a) do { if (__any((a) < 1.f)) { if (hi == 0) al_l[r32] = (a); asm volatile("s_waitcnt lgkmcnt(0)" ::: "memory"); \
    _Pragma("unroll") for (int d = 0; d < NDV; ++d) _Pragma("unroll") for (int r = 0; r < 16; ++r) o[d][r] *= al_l[crow(r, hi)]; } } while (0)
    f32x16 p0, p1; float mn, al; bf16x8 pa0, pa1, pa2, pa3; const int NTL = seq / 64;
    pa0 = pa1 = pa2 = pa3 = (bf16x8){0, 0, 0, 0, 0, 0, 0, 0};
    const LAS char* vbl = (const LAS char*)V_lds + v_rd_base(lane);
    float moff = 0.f;
#define PSM(P0, P1, MN, AL, FIRST) do { if constexpr (SHIFT) partialSM_shift(P0, P1, moff, AL, qr[ND0 - 1], FIRST, hi); else partialSM(P0, P1, m_reg, MN, AL, C, thr_raw); } while (0)
#define KIMG(b) ((bf16_t*)((char*)K_lds + (b) * SHM_K))
#define NXT3(b) ((b) == 2 ? 0 : (b) + 1)
    __syncthreads();
    SLOAD(A, 0); SLOAD(B, 64);
    SWAIT(); SWRITE(0, A);
    if (g == 1) { asm volatile("s_waitcnt vmcnt(0)" ::: "memory"); SWRITE(1, B); }
    SLOAD(A, (1 + g) * 64); SLOAD(B, (2 + g) * 64);
    __syncthreads();
    if (g == 1) { SBAR(); __syncthreads(); SBAR(); }
    int iq = 0, ip = 0, iw = 1 + g;
#define STEP(S, k) do { SBAR(); __builtin_amdgcn_s_setprio(1);                                                             \
        if constexpr (NDV == 2) mphase2<ND0>(p0, p1, o, (const LAS char*)K_lds + iq * SHM_K, vbl + ip * SHM_V, qr, pa0, pa1, pa2, pa3, r32, hi, \
                                             [&]() { PSM(p0, p1, mn, al, (k) == 0); });                                    \
        else { qkt<ND0>(p0, p1, KIMG(iq), qr, r32, hi); if ((k) > 0) pv_all<NDV>(o, vb0 + ip * SHM_V, pa0, pa1, pa2, pa3); PSM(p0, p1, mn, al, (k) == 0); }  \
        SBAR(); __builtin_amdgcn_s_setprio(0); __syncthreads(); SBAR();                                                   \
        finishSM(p0, p1, al, l_reg, pa0, pa1, pa2, pa3);                                                                  \
        SWAIT(); if ((k) + 1 + g < NTL) SWRITE(iw, S);                                                                    \
        { const int jn = (k) + 3 + g < NTL ? (k) + 3 + g : NTL - 1; SLOAD(S, jn * 64); }                                  \
        RESC(al); SBAR(); __syncthreads(); SBAR();                                                                        \
        ip = iq; iq = NXT3(iq); iw = NXT3(iw); } while (0)
    for (int k = 0; k < NTL; k += 2) { STEP(A, k); STEP(B, k + 1); }
#undef STEP
    SBAR(); pv_all<NDV>(o, vb0 + ip * SHM_V, pa0, pa1, pa2, pa3);
    if (g == 0) { SBAR(); __syncthreads(); SBAR(); }
#undef KIMG
#undef PSM
#undef NXT3
    if (hi == 0) li_l[r32] = l_reg; asm volatile("s_waitcnt lgkmcnt(0)" ::: "memory");
    float rli[16];
#pragma unroll
    for (int r = 0; r < 16; ++r) rli[r] = __builtin_amdgcn_rcpf(li_l[crow(r, hi)]);
    bf16_t* Owv = Ow + (size_t)(wid * 32) * ldo;
#pragma unroll
    for (int r = 0; r < 16; ++r) { const int orow = crow(r, hi);
#pragma unroll
        for (int d0 = 0; d0 < NDV; ++d0) Owv[(size_t)orow * ldo + d0 * 32 + r32] = f2bf(o[d0][r] * rli[r]); }
#undef SLOAD
#undef SWRITE
#undef SWAIT
#undef RESC
}

DEVI void phase_mla_attn(const Params& p, int, char* lds) {
    const int tid = tidx(), wid = tid >> 6, lane = tid & 63, r32 = lane & 31, hi = lane >> 5;
    const int sc = (tid & 15) * 8;
    const bf16_t* Q = WSB(OFF_Q); const bf16_t* KV = WSB(OFF_KV); const bf16_t* KR = WSB(OFF_KR); bf16_t* O = WSB(OFF_O);
    const int Gn = gdim(), bi = bidx();
    const bool xcd_order = (Gn & 7) == 0 && ((NBATCH * 8 * 16) % Gn) == 0 && (((NBATCH * 8 * 16) / 8) % (Gn >> 3)) == 0;
    for (int u0 = bi, it = 0; u0 < NBATCH * 8 * 16; u0 += Gn, ++it) {
        int u = u0;
        if (xcd_order) { const int xcd = bi & 7, slot = bi >> 3, per = Gn >> 3; u = xcd * ((NBATCH * 8 * 16) >> 3) + it * per + slot; }
        const int qb = u & 15, h = (u >> 4) & 7, b = u >> 7;
        const size_t t0 = (size_t)b * SEQ;
        const bf16_t* Qw = Q + (t0 + qb * 256 + wid * 32 + r32) * 768 + h * 96 + hi * 8;
        const bool kact = sc < 96, vact = sc < 64;
        const bf16_t* kp; int kstr;
        if (sc < 64) { kp = KV + t0 * 1024 + h * 128 + sc; kstr = 1024; } else if (sc < 96) { kp = KR + t0 * 32 + (sc - 64); kstr = 32; }
        else { kp = WSB(OFF_ONES) + (sc - 96); kstr = 0; }
        const bf16_t* vp = KV + t0 * 1024 + h * 128 + 64 + (sc & 63);
        const size_t qtok = t0 + qb * 256 + wid * 32 + r32;
        attn_body_pp<96, 64, true>(Qw, kp, kstr, vp, 1024, O + (t0 + qb * 256) * 512 + h * 64, 512, SEQ, 0.10206207261596577f, lds,
                          WSF(OFF_ROPE_C) + qtok * 16 + hi * 8, WSF(OFF_ROPE_S) + qtok * 16 + hi * 8);
    }
}
DEVI void phase_x_attn(const Params& p, int, char* lds) {
    const int tid = tidx(), wid = tid >> 6, lane = tid & 63, r32 = lane & 31, hi = lane >> 5;
    const int sc = (tid & 15) * 8;
    const bf16_t* Q = WSB(OFF_QX); const bf16_t* KV = WSB(OFF_KVX); bf16_t* O = WSB(OFF_OX);
    for (int u = bidx(); u < NBATCH * 4 * 16; u += gdim()) {
        const int qb = u & 15, h = (u >> 4) & 3, b = u >> 6;
        const size_t t0 = (size_t)b * SEQ;
        const bf16_t* Qw = Q + (t0 + qb * 256 + wid * 32 + r32) * 512 + h * 128 + hi * 8;
        const bf16_t* kp = KV + (size_t)b * 256 * 1024 + h * 256 + sc;
        const bf16_t* vp = kp + 128;
        attn_body<128, 128>(Qw, kp, 1024, true, vp, 1024, true, O + (t0 + qb * 256) * 512 + h * 128, 512, 256, 0.08838834764831845f, lds);
    }
}

DEVI void hy_pre_waves(const Params& p, int l, char* tile_lds, int wv, int nwv) {
    const int tid = tidx(), lane = tid & 63, l8 = lane >> 3, cc = (lane & 7) * 8;
    bf16_t* tile = (bf16_t*)tile_lds;
    const bf16_t* PH = WSB(OFF_PH);
    const float* cw = INF(I_HYCONV) + l * 3 * 1536;
    const int ustep = gdim() * nwv;
    bf16x8 xv[8][3];
#define HP_LOAD(u_) do { const int cb_ = (u_) % 24, tb_ = (u_) / 24, b_ = tb_ >> 6, t0_ = (tb_ & 63) * 64, ch0_ = cb_ * 64 + cc;                       \
        _Pragma("unroll") for (int i = 0; i < 8; ++i) { const int tt_ = t0_ + l8 + 8 * i;                                                               \
            _Pragma("unroll") for (int d = 0; d < 3; ++d) { const int ts_ = tt_ + d - 1;                                                                 \
                xv[i][d] = (ts_ >= 0 && ts_ < SEQ) ? *(const bf16x8*)(PH + ((size_t)b_ * SEQ + ts_) * 1536 + ch0_) : (bf16x8){0, 0, 0, 0, 0, 0, 0, 0}; } } } while (0)
    int u = bidx() * nwv + wv;
    if (u < 1024 * 24) HP_LOAD(u);
    for (; u < 1024 * 24; u += ustep) {
        const int cb = u % 24, tb = u / 24, b = tb >> 6, t0 = (tb & 63) * 64;
        float w0[8], w1[8], w2[8];
#pragma unroll
        for (int e = 0; e < 8; ++e) { const int ch0 = cb * 64 + cc; w0[e] = cw[ch0 + e]; w1[e] = cw[1536 + ch0 + e]; w2[e] = cw[3072 + ch0 + e]; }
        bf16x8 yv[8];
#pragma unroll
        for (int i = 0; i < 8; ++i) {
            float a[8], x0[8], x1[8], x2[8]; unpack8(xv[i][0], x0); unpack8(xv[i][1], x1); unpack8(xv[i][2], x2);
#pragma unroll
            for (int e = 0; e < 8; ++e) a[e] = w0[e] * x0[e] + w1[e] * x1[e] + w2[e] * x2[e];
            yv[i] = pack8(a);
        }
        if (u + ustep < 1024 * 24) HP_LOAD(u + ustep);
#pragma unroll
        for (int i = 0; i < 8; ++i)
#pragma unroll
            for (int e = 0; e < 8; ++e) tile[(cc + e) * 72 + l8 + 8 * i] = (bf16_t)yv[i][e];
        __builtin_amdgcn_wave_barrier(); asm volatile("s_waitcnt lgkmcnt(0)" ::: "memory");
#pragma unroll
        for (int i = 0; i < 8; ++i) {
            const int cl = l8 + 8 * i, ch = cb * 64 + cl, which = ch >> 9, c = ch & 511;
            bf16_t* dst = WSB(which == 0 ? OFF_VT : (which == 1 ? OFF_X1T : OFF_X2T));
            *(bf16x8*)(dst + ((size_t)c * NBATCH + b) * SEQ + t0 + cc) = *(const bf16x8*)(tile + cl * 72 + cc);
        }
        __builtin_amdgcn_wave_barrier(); asm volatile("s_waitcnt lgkmcnt(0)" ::: "memory");
    }
#undef HP_LOAD
}
DEVI void phase_s5(const Params& p, int l, char* lds) {
    const int tid = tidx(), wid = tid >> 6, lane = tid & 63, c16 = lane & 15, q4 = lane >> 4;
    if (wid >= 4) { hy_pre_waves(p, l, lds + 51200 + (wid - 4) * 9216, wid - 4, 4); return; }
    f32x2* buS = (f32x2*)(lds + wid * 12800);
    bf16_t* sS = (bf16_t*)(lds + wid * 12800 + 8192);
    const bf16_t* PS = WSB(OFF_PS);
    for (int u = wid * gdim() + bidx(); u < NBATCH * 32 * 2; u += 4 * gdim()) {
        const int dir = u & 1, g = (u >> 1) & 31, b = u >> 6;
        bf16_t* Y = WSB(dir == 0 ? OFF_YSF : OFF_YSB);
        const int gbase = (l * 2 + dir) * 32 + g;
        const float delta = expf(INF(I_S5STEP)[gbase]);
        float lbr, lbi;
        { const float lr = INF(I_S5LRE)[gbase * 64 + lane], li = INF(I_S5LIM)[gbase * 64 + lane];
          const float mag = expf(lr * delta); float sn, cs; sincosf(li * delta, &sn, &cs); lbr = mag * cs; lbi = mag * sn; }
        bf16x8 bre[4], bim[4];
#pragma unroll
        for (int f = 0; f < 4; ++f) {
            const int ps = gbase * 64 + 16 * f + c16;
            const float lr = INF(I_S5LRE)[ps], li = INF(I_S5LIM)[ps];
            const float mag = expf(lr * delta); float sn, cs; sincosf(li * delta, &sn, &cs);
            const float nr = mag * cs - 1.f, ni = mag * sn, den = lr * lr + li * li;
            const float wr_ = (nr * lr + ni * li) / den, wi_ = (ni * lr - nr * li) / den;
            float fr_[8], fi_[8];
#pragma unroll
            for (int e = 0; e < 8; ++e) {
                float x = 0.f, y = 0.f;
                if (q4 < 2) { x = INF(I_S5BRE)[(size_t)ps * 16 + 8 * q4 + e]; y = INF(I_S5BIM)[(size_t)ps * 16 + 8 * q4 + e]; }
                fr_[e] = wr_ * x - wi_ * y; fi_[e] = wr_ * y + wi_ * x;
            }
            bre[f] = pack8(fr_); bim[f] = pack8(fi_);
        }
        bf16x8 cf[4], dfr;
        {
            const float* cre = INF(I_S5CRE) + ((size_t)gbase * 16 + c16) * 64;
            const float* cim = INF(I_S5CIM) + ((size_t)gbase * 16 + c16) * 64;
#pragma unroll
            for (int kb = 0; kb < 4; ++kb) {
                float f[8];
#pragma unroll
                for (int e = 0; e < 8; e += 2) { const int pp = (32 * kb + 8 * q4 + e) >> 1; f[e] = cre[pp]; f[e + 1] = -cim[pp]; }
                cf[kb] = pack8(f);
            }
            const float dsk = (dir == 0) ? INF(I_S5D)[l * 512 + g * 16 + c16] : 0.f;
            float f[8];
#pragma unroll
            for (int e = 0; e < 8; ++e) f[e] = (8 * q4 + e == c16) ? dsk : 0.f;
            dfr = pack8(f);
        }
        float sr = 0.f, si = 0.f;
        const bf16_t* ubase = PS + (size_t)b * SEQ * 512 + g * 16 + 8 * (q4 & 1);
        bf16_t* ybase = Y + (size_t)b * SEQ * 512 + g * 16 + c16;
        auto loadu = [&](int blk) -> bf16x8 {
            const int bc = blk < 256 ? blk : 255;
            const int st = bc * 16 + c16, t = dir == 0 ? st : SEQ - 1 - st;
            return *(const bf16x8*)(ubase + (size_t)t * 512);
        };
        auto projA = [&](const bf16x8 ua) {
#pragma unroll
            for (int f = 0; f < 4; ++f) {
                const f32x4 z = {0.f, 0.f, 0.f, 0.f};
                const f32x4 are = __builtin_amdgcn_mfma_f32_16x16x32_bf16(ua, bre[f], z, 0, 0, 0);
                const f32x4 aim = __builtin_amdgcn_mfma_f32_16x16x32_bf16(ua, bim[f], z, 0, 0, 0);
#pragma unroll
                for (int r = 0; r < 4; ++r) buS[(4 * q4 + r) * 64 + 16 * f + c16] = (f32x2){are[r], aim[r]};
            }
        };
        auto scanB = [&](const f32x2 (&bu)[16]) {
#pragma unroll
            for (int i = 0; i < 16; ++i) {
                const float nsr = fmaf(lbr, sr, fmaf(-lbi, si, bu[i][0])), nsi = fmaf(lbr, si, fmaf(lbi, sr, bu[i][1]));
                sr = nsr; si = nsi;
                *(unsigned*)(sS + i * 136 + 2 * lane) = pk2(sr, si);
            }
        };
        auto outC = [&](const bf16x8 (&a)[4], const bf16x8 up, const int blk) {
            f32x4 acc = {0.f, 0.f, 0.f, 0.f};
            acc = __builtin_amdgcn_mfma_f32_16x16x32_bf16(up, dfr, acc, 0, 0, 0);
#pragma unroll
            for (int kb = 0; kb < 4; ++kb) acc = __builtin_amdgcn_mfma_f32_16x16x32_bf16(a[kb], cf[kb], acc, 0, 0, 0);
#pragma unroll
            for (int r = 0; r < 4; ++r) {
                const int st = blk * 16 + 4 * q4 + r, t = dir == 0 ? st : SEQ - 1 - st;
                ybase[(size_t)t * 512] = f2bf(acc[r]);
            }
        };
        bf16x8 U0 = loadu(0), U1 = loadu(1), U2 = loadu(2), U3 = loadu(3), U4 = loadu(4), U5 = loadu(5), U6 = loadu(6), U7;
        __builtin_amdgcn_wave_barrier();
        projA(U0);
        { f32x2 bu[16];
#pragma unroll
          for (int i = 0; i < 16; ++i) bu[i] = buS[i * 64 + lane];
          projA(U1);
          scanB(bu); }
#define S5STEP(UP, UN, UL, blk_) do { bf16x8 a[4]; f32x2 bu[16];                                                                       \
            _Pragma("unroll") for (int kb = 0; kb < 4; ++kb) a[kb] = *(const bf16x8*)(sS + c16 * 136 + kb * 32 + 8 * q4);     \
            _Pragma("unroll") for (int i = 0; i < 16; ++i) bu[i] = buS[i * 64 + lane];                                            \
            projA(UN);                                                                                                                  \
            outC(a, UP, (blk_) - 1);                                                                                                                       \
            scanB(bu);                                                                                                                                     \
            UL = loadu((blk_) + 6); } while (0)
        asm volatile("" :: "v"(U2), "v"(U3), "v"(U4), "v"(U5), "v"(U6));
#pragma nounroll
        for (int base = 1; base < 257; base += 8) {
            S5STEP(U0, U2, U7, base + 0); S5STEP(U1, U3, U0, base + 1); S5STEP(U2, U4, U1, base + 2); S5STEP(U3, U5, U2, base + 3);
            S5STEP(U4, U6, U3, base + 4); S5STEP(U5, U7, U4, base + 5); S5STEP(U6, U0, U5, base + 6); S5STEP(U7, U1, U6, base + 7);
        }
#undef S5STEP
        __builtin_amdgcn_wave_barrier(); asm volatile("s_waitcnt lgkmcnt(0)" ::: "memory");
    }
}

DEVI void phase_hy_post(const Params& p, int, char* lds) {
    {
        bf16_t* F = WSB(OFF_YSF); const bf16_t* B = WSB(OFF_YSB);
        const size_t n = (size_t)T_ * 64, step = (size_t)gdim() * NTHR;
        for (size_t i = (size_t)bidx() * NTHR + tidx(); i < n; i += 4 * step) {
            bf16x8 fv[4], bv[4];
#pragma unroll
            for (int j = 0; j < 4; ++j) if (i + j * step < n) { fv[j] = *(const bf16x8*)(F + (i + j * step) * 8); bv[j] = *(const bf16x8*)(B + (i + j * step) * 8); }
#pragma unroll
            for (int j = 0; j < 4; ++j) if (i + j * step < n) {
                float x[8], y[8]; unpack8(fv[j], x); unpack8(bv[j], y);
#pragma unroll
                for (int e = 0; e < 8; ++e) x[e] = gelu_tanh(x[e] + y[e]);
                *(bf16x8*)(F + (i + j * step) * 8) = pack8(x);
            }
        }
    }
    const int tid = tidx(), wid = tid >> 6, lane = tid & 63, l8 = lane >> 3, c8 = (lane & 7) * 8;
    bf16_t* tile = (bf16_t*)(lds + wid * 9216);
    const bf16_t* ZT = WSB(OFF_ZT); bf16_t* Z = WSB(OFF_Z);
    for (int u = bidx() * 8 + wid; u < 8 * NBATCH * 64; u += gdim() * 8) {
        const int cb = u & 7, tb = (u >> 3) & 63, b = u >> 9, t0 = tb * 64;
        bf16x8 v[8];
#pragma unroll
        for (int i = 0; i < 8; ++i) v[i] = *(const bf16x8*)(ZT + ((size_t)(cb * 64 + l8 + 8 * i) * NBATCH + b) * SEQ + t0 + c8);
#pragma unroll
        for (int i = 0; i < 8; ++i)
#pragma unroll
            for (int e = 0; e < 8; ++e) tile[(c8 + e) * 72 + l8 + 8 * i] = (bf16_t)v[i][e];
        __builtin_amdgcn_wave_barrier(); asm volatile("s_waitcnt lgkmcnt(0)" ::: "memory");
#pragma unroll
        for (int i = 0; i < 8; ++i) { const int tl = l8 + 8 * i;
            *(bf16x8*)(Z + ((size_t)b * SEQ + t0 + tl) * 512 + cb * 64 + c8) = *(const bf16x8*)(tile + tl * 72 + c8); }
        __builtin_amdgcn_wave_barrier(); asm volatile("s_waitcnt lgkmcnt(0)" ::: "memory");
    }
}

template <int ORD>
DEVI void hy_conv_channel(const Params& p, int l, char* lds, const int c) {
    const int tid = tidx(), wid = tid >> 6, lane = tid & 63, i16 = lane & 15, g = lane >> 4;
    const bf16_t* UT = WSB(ORD == 0 ? OFF_VT : OFF_Z1T);
    const bf16_t* GT = WSB(ORD == 0 ? OFF_X1T : OFF_X2T);
    bf16_t* OT = WSB(ORD == 0 ? OFF_Z1T : OFF_ZT);
    const bf16_t* Rt = WSB(OFF_RTAB) + (size_t)ORD * 512 * 8192;
    const float* biasv = INF(I_HYBIAS) + (l * 2 + ORD) * 512;
    const int q = (8 - (i16 & 7)) & 7;
    const int laneBase = q * 16384 + (4096 - i16 + 8 * g - q) * 2;
    {
        asm volatile("s_waitcnt vmcnt(0)" ::: "memory");
        __syncthreads();
        {
            const bf16_t* R = Rt + (size_t)c * 8192;
#pragma unroll
            for (int it = 0; it < 2; ++it) {
                const int w = tid + 512 * it;
                const u32x4 lo = *(const u32x4*)(R + 8 * w);
                u32x4 hi4 = {0u, 0u, 0u, 0u};
                if (w < 1023) hi4 = *(const u32x4*)(R + 8 * w + 8);
                const unsigned d[8] = {lo[0], lo[1], lo[2], lo[3], hi4[0], hi4[1], hi4[2], hi4[3]};
#pragma unroll
                for (int qq = 0; qq < 8; ++qq) {
                    const int m = qq >> 1;
                    u32x4 o;
                    if ((qq & 1) == 0) { o = (u32x4){d[m], d[m + 1], d[m + 2], d[m + 3]}; }
                    else {
#pragma unroll
                        for (int j = 0; j < 4; ++j) o[j] = __builtin_amdgcn_alignbit(d[m + j + 1], d[m + j], 16);
                    }
                    *(u32x4*)(lds + qq * 16384 + w * 16) = o;
                }
            }
        }
        __syncthreads();
        const float bias = biasv[c];
        const size_t rowb = ((size_t)c * NBATCH + i16) * SEQ;
        for (int hf = 0; hf < 2; ++hf) {
            const int T0 = hf * 2048 + wid * 256;
            f32x4 acc[16];
#pragma unroll
            for (int a = 0; a < 16; ++a) acc[a] = (f32x4){0.f, 0.f, 0.f, 0.f};
            bf16x8 W[16];
            const int base0 = laneBase - 32 * (T0 >> 4);
#pragma unroll
            for (int a = 0; a < 16; ++a) W[a] = *(const bf16x8*)(lds + base0 - 32 * a);
            const bf16_t* up = UT + rowb + 8 * g;
            bf16x8 ub[4];
#pragma unroll
            for (int j = 0; j < 4; ++j) ub[j] = *(const bf16x8*)(up + 32 * j);
            for (int it = 0; it < 16; ++it) {
#pragma unroll
                for (int uu = 0; uu < 8; ++uu) {
                    const int n = it * 8 + uu;
                    if (n > 0) {
                        const int ad = base0 + 64 * n;
                        W[(16 - 2 * uu) & 15] = *(const bf16x8*)(lds + ad);
                        W[(17 - 2 * uu) & 15] = *(const bf16x8*)(lds + ad - 32);
                    }
                    const bf16x8 bcur = ub[uu & 3];
                    if (n + 4 < 128) ub[uu & 3] = *(const bf16x8*)(up + 32 * (n + 4));
#pragma unroll
                    for (int a = 0; a < 16; ++a) acc[a] = __builtin_amdgcn_mfma_f32_16x16x32_bf16(W[(a + 16 - 2 * uu) & 15], bcur, acc[a], 0, 0, 0);
                }
            }
#pragma unroll
            for (int a = 0; a < 16; ++a) {
                const size_t idx = rowb + T0 + 16 * a + 4 * g;
                const u32x2 uv = *(const u32x2*)(UT + idx), gv = *(const u32x2*)(GT + idx);
                f32x4 o;
                o[0] = bflo(gv[0]) * (acc[a][0] + bias * bflo(uv[0]));
                o[1] = bfhi(gv[0]) * (acc[a][1] + bias * bfhi(uv[0]));
                o[2] = bflo(gv[1]) * (acc[a][2] + bias * bflo(uv[1]));
                o[3] = bfhi(gv[1]) * (acc[a][3] + bias * bfhi(uv[1]));
                *(u32x2*)(OT + idx) = pack4(o);
            }
        }
    }
}

DEVI void phase_hy_conv01(const Params& p, int l, char* lds) {
    for (int c = bidx(); c < 512; c += gdim()) { hy_conv_channel<0>(p, l, lds, c); hy_conv_channel<1>(p, l, lds, c); }
}
template <int ORD> DEVI void phase_hy_conv(const Params& p, int l, char* lds) { for (int c = bidx(); c < 512; c += gdim()) hy_conv_channel<ORD>(p, l, lds, c); }

template <int MODE> struct EpiMerge {
    static constexpr bool PERM = true;
    bf16_t* Y; bf16_t* MG; const float* bias;
    DEVI void operator()(const f32x4 (&acc)[2][2][4][2], const pg8::Unit& u, int wr, int wc, int fr, int fq) const {
        const int row0 = u.pm * 256 + wr * 64 + fr, col0 = u.pn * 256 + wc * 32 + 8 * fq;
        float bb[2][8];
        if (MODE >= 2) {
#pragma unroll
            for (int bj = 0; bj < 2; ++bj) { const f32x4 b0 = *(const f32x4*)(bias + col0 + bj * 128), b1 = *(const f32x4*)(bias + col0 + bj * 128 + 4);
#pragma unroll
                for (int e = 0; e < 4; ++e) { bb[bj][e] = b0[e]; bb[bj][4 + e] = b1[e]; } }
        }
#pragma unroll
        for (int ai = 0; ai < 2; ++ai) {
            bf16x8 yv[4][2], gv[4][2];
            if (MODE >= 1) {
#pragma unroll
                for (int m = 0; m < 4; ++m)
#pragma unroll
                    for (int bj = 0; bj < 2; ++bj) { const size_t idx = (size_t)(row0 + ai * 128 + m * 16) * DM + col0 + bj * 128;
                        yv[m][bj] = *(const bf16x8*)(Y + idx); if (MODE == 3) gv[m][bj] = *(const bf16x8*)(MG + idx); }
            }
#pragma unroll
            for (int m = 0; m < 4; ++m)
#pragma unroll
                for (int bj = 0; bj < 2; ++bj) {
                    const size_t idx = (size_t)(row0 + ai * 128 + m * 16) * DM + col0 + bj * 128;
                    float a[8] = {acc[ai][bj][m][0][0], acc[ai][bj][m][0][1], acc[ai][bj][m][0][2], acc[ai][bj][m][0][3],
                                  acc[ai][bj][m][1][0], acc[ai][bj][m][1][1], acc[ai][bj][m][1][2], acc[ai][bj][m][1][3]};
                    if (MODE == 0) {
#pragma unroll
                        for (int e = 0; e < 8; ++e) a[e] = sigmoid_(a[e]);
                        *(bf16x8*)(Y + idx) = pack8(a);
                    } else if (MODE == 1) {
                        float y[8]; unpack8(yv[m][bj], y);
#pragma unroll
                        for (int e = 0; e < 8; ++e) a[e] *= y[e];
                        *(bf16x8*)(Y + idx) = pack8(a);
                    } else {
                        float y[8]; unpack8(yv[m][bj], y);
#pragma unroll
                        for (int e = 0; e < 8; ++e) a[e] = sigmoid_(a[e] + bb[bj][e]) * y[e];
                        if (MODE == 3) { float g[8]; unpack8(gv[m][bj], g);
#pragma unroll
                            for (int e = 0; e < 8; ++e) a[e] += g[e]; }
                        *(bf16x8*)(MG + idx) = pack8(a);
                    }
                }
        }
    }
};
template <int MODE> struct EpiFused {
    static constexpr bool PERM = true;
    bf16_t* MG; const float* bias; char* ldsb;
    static constexpr int NREG = 18;
    mutable unsigned sq[NREG];
    DEVI void operator()(const f32x4 (&acc)[2][2][4][2], const pg8::Unit& u, int st, int wr, int wc, int fr, int fq) const {
        const int row0 = u.pm * 256 + wr * 64 + fr, col0 = u.pn * 256 + wc * 32 + 8 * fq;
        LAS unsigned* sx = (LAS unsigned*)(ldsb + LDS_SQX) + tidx();
        if (st == 0) {
#pragma unroll
            for (int bj = 0; bj < 2; ++bj) {
                const f32x4 b0 = *(const f32x4*)(bias + col0 + bj * 128), b1 = *(const f32x4*)(bias + col0 + bj * 128 + 4);
#pragma unroll
                for (int ai = 0; ai < 2; ++ai)
#pragma unroll
                    for (int m = 0; m < 4; ++m)
#pragma unroll
                        for (int n = 0; n < 2; ++n) {
                            unsigned w = 0;
#pragma unroll
                            for (int q = 0; q < 4; ++q) { const float sv = sigmoid_(acc[ai][bj][m][n][q] + (n ? b1[q] : b0[q]));
                                w |= (unsigned)(sv * 255.f + 0.5f) << (8 * q); }
                            { constexpr int NR = NREG; const int wi = ((ai * 2 + bj) * 4 + m) * 2 + n; if (wi < NR) sq[wi < NR ? wi : 0] = w; else sx[(wi - NR) * 512] = w; }
                        }
            }
        } else {
#pragma unroll
            for (int ai = 0; ai < 2; ++ai) {
                bf16x8 gv[4][2];
                if (MODE == 3) {
#pragma unroll
                    for (int m = 0; m < 4; ++m)
#pragma unroll
                        for (int bj = 0; bj < 2; ++bj) gv[m][bj] = *(const bf16x8*)(MG + (size_t)(row0 + ai * 128 + m * 16) * DM + col0 + bj * 128);
                }
#pragma unroll
                for (int m = 0; m < 4; ++m)
#pragma unroll
                    for (int bj = 0; bj < 2; ++bj) {
                        float a[8];
#pragma unroll
                        for (int n = 0; n < 2; ++n) { const int wi = ((ai * 2 + bj) * 4 + m) * 2 + n; const unsigned w = wi < NREG ? sq[wi < NREG ? wi : 0] : sx[(wi - NREG) * 512];
#pragma unroll
                            for (int q = 0; q < 4; ++q) a[4 * n + q] = acc[ai][bj][m][n][q] * ((float)((w >> (8 * q)) & 0xffu) * (1.f / 255.f)); }
                        if (MODE == 3) { float g[8]; unpack8(gv[m][bj], g);
#pragma unroll
                            for (int e = 0; e < 8; ++e) a[e] += g[e]; }
                        *(bf16x8*)(MG + (size_t)(row0 + ai * 128 + m * 16) * DM + col0 + bj * 128) = pack8(a);
                    }
            }
        }
    }
};
struct MergeDesc {
    static constexpr int NS = 9;
    const char* tab;
    DEVI void get(int st, const char*& A, const char*& B, int& K, int& lda, int& bm, int& ba) const {
        const u32x4 v = *(const LAS u32x4*)((const LAS char*)tab + st * 16);
        A = (const char*)(((unsigned long long)(unsigned)__builtin_amdgcn_readfirstlane((int)v[1]) << 32) | (unsigned)__builtin_amdgcn_readfirstlane((int)v[0]));
        B = (const char*)(((unsigned long long)(unsigned)__builtin_amdgcn_readfirstlane((int)v[3]) << 32) | (unsigned)__builtin_amdgcn_readfirstlane((int)v[2]));
        const bool gate = (st == 0) | (st == 2) | (st == 5) | (st == 7);
        K = gate ? DM : 512; lda = K;
        const bool glu = (st == 3) | (st == 4);
        bm = glu ? 2 : 1; ba = (st == 4) ? 1 : 0;
    }
};
struct EpiFusedN {
    static constexpr bool PERM = true;
    bf16_t* MG; const float* gbias; char* ldsb;
    static constexpr int NREG = 18;
    mutable unsigned sq[NREG];
    DEVI unsigned gw(LAS unsigned* sx, int wi) const { return wi < NREG ? sq[wi < NREG ? wi : 0] : sx[(wi - NREG) * 512]; }
    DEVI void operator()(const f32x4 (&acc)[2][2][4][2], const pg8::Unit& u, int st, int wr, int wc, int fr, int fq) const {
        const int row0 = u.pm * 256 + wr * 64 + fr, col0 = u.pn * 256 + wc * 32 + 8 * fq;
        LAS unsigned* sx = (LAS unsigned*)(ldsb + LDS_SQX) + tidx();
        const bool gate = (st == 0) | (st == 2) | (st == 5) | (st == 7);
        if (gate) {
            const float* bias = gbias + (st == 0 ? 0 : st == 2 ? 1 : st == 5 ? 2 : 3) * DM;
#pragma unroll
            for (int bj = 0; bj < 2; ++bj) {
                const f32x4 b0 = *(const f32x4*)(bias + col0 + bj * 128), b1 = *(const f32x4*)(bias + col0 + bj * 128 + 4);
#pragma unroll
                for (int ai = 0; ai < 2; ++ai)
#pragma unroll
                    for (int m = 0; m < 4; ++m)
#pragma unroll
                        for (int n = 0; n < 2; ++n) {
                            unsigned w = 0;
#pragma unroll
                            for (int q = 0; q < 4; ++q) { const float sv = sigmoid_(acc[ai][bj][m][n][q] + (n ? b1[q] : b0[q]));
                                w |= (unsigned)(sv * 255.f + 0.5f) << (8 * q); }
                            { constexpr int NR = NREG; const int wi = ((ai * 2 + bj) * 4 + m) * 2 + n; if (wi < NR) sq[wi < NR ? wi : 0] = w; else sx[(wi - NR) * 512] = w; }
                        }
            }
        } else if ((st == 3) | (st == 4)) {
            const int h = st - 3;
#pragma unroll
            for (int ai = 0; ai < 2; ++ai) {
                bf16x8 gv[4];
#pragma unroll
                for (int m = 0; m < 4; ++m) gv[m] = *(const bf16x8*)(MG + (size_t)(row0 + ai * 128 + m * 16) * DM + col0 + h * 128);
#pragma unroll
                for (int m = 0; m < 4; ++m) {
                    float a[8], g[8]; unpack8(gv[m], g);
#pragma unroll
                    for (int bj = 0; bj < 2; ++bj) { const unsigned w = h == 0 ? gw(sx, ((ai * 2 + 0) * 4 + m) * 2 + bj) : gw(sx, ((ai * 2 + 1) * 4 + m) * 2 + bj);
#pragma unroll
                        for (int q = 0; q < 4; ++q) a[4 * bj + q] = g[4 * bj + q] + acc[ai][bj][m][0][q] * sigmoid_(acc[ai][bj][m][1][q]) * ((float)((w >> (8 * q)) & 0xffu) * (1.f / 255.f)); }
                    *(bf16x8*)(MG + (size_t)(row0 + ai * 128 + m * 16) * DM + col0 + h * 128) = pack8(a);
                }
            }
        } else {
            const bool accm = st > 1;
#pragma unroll
            for (int ai = 0; ai < 2; ++ai) {
                bf16x8 gv[4][2];
                if (accm) {
#pragma unroll
                    for (int m = 0; m < 4; ++m)
#pragma unroll
                        for (int bj = 0; bj < 2; ++bj) gv[m][bj] = *(const bf16x8*)(MG + (size_t)(row0 + ai * 128 + m * 16) * DM + col0 + bj * 128);
                } else {
#pragma unroll
                    for (int m = 0; m < 4; ++m)
#pragma unroll
                        for (int bj = 0; bj < 2; ++bj) gv[m][bj] = (bf16x8){0, 0, 0, 0, 0, 0, 0, 0};
                }
#pragma unroll
                for (int m = 0; m < 4; ++m)
#pragma unroll
                    for (int bj = 0; bj < 2; ++bj) {
                        float a[8];
#pragma unroll
                        for (int n = 0; n < 2; ++n) { const unsigned w = gw(sx, ((ai * 2 + bj) * 4 + m) * 2 + n);
#pragma unroll
                            for (int q = 0; q < 4; ++q) a[4 * n + q] = acc[ai][bj][m][n][q] * ((float)((w >> (8 * q)) & 0xffu) * (1.f / 255.f)); }
                        { float g[8]; unpack8(gv[m][bj], g);
#pragma unroll
                          for (int e = 0; e < 8; ++e) a[e] += g[e]; }
                        *(bf16x8*)(MG + (size_t)(row0 + ai * 128 + m * 16) * DM + col0 + bj * 128) = pack8(a);
                    }
            }
        }
    }
};
struct GluOrder {
    pg8::StaticOrder S4;
    DEVI bool next(int i, pg8::Unit& u) const { pg8::Unit v; if (!S4.next(i >> 1, v)) return false; u.pm = v.pm; u.pn = 2 * v.pn + (i & 1); return true; }
    DEVI void a_ready(const pg8::Unit&) const {}
    DEVI void done(const pg8::Unit&) const {}
};
struct EpiGlu {
    static constexpr bool PERM = false;
    bf16_t* Y;
    DEVI void operator()(const f32x4 (&acc)[2][2][4][2], const pg8::Unit& u, int wr, int wc, int fr, int fq) const {
        const int row0 = u.pm * 256 + wr * 64 + fr;
#pragma unroll
        for (int ai = 0; ai < 2; ++ai)
#pragma unroll
            for (int m = 0; m < 4; ++m)
#pragma unroll
                for (int bj = 0; bj < 2; ++bj) {
                    const int hc = u.pn * 128 + bj * 64 + wc * 16 + 4 * fq;
                    f32x4 o;
#pragma unroll
                    for (int q = 0; q < 4; ++q) o[q] = acc[ai][bj][m][0][q] * sigmoid_(acc[ai][bj][m][1][q]);
                    *(u32x2*)(Y + (size_t)(row0 + ai * 128 + m * 16) * DM + hc) = pack4(o);
                }
    }
};
DEVI void phase_merge(const Params& p, int l, char* lds) {
    const float* gb = INF(I_GATEB) + l * 4 * DM;
    bf16_t* MG = WSB(OFF_MERGED); bf16_t* YB = WSB(OFF_YB);
    const bf16_t* H = WSB(OFF_H); const bf16_t* YS = WSB(OFF_YSF);
    pg8::StaticOrder S; S.init(T_, DM, gdim(), bidx());
    if (tidx() == 0) {
        const bf16_t** t = (const bf16_t**)(lds + LDS_TAB);
        t[0] = H;  t[1] = WW(W_G);                          t[2] = WSB(OFF_ZA); t[3] = WW(W_OA);
        t[4] = H;  t[5] = WW(W_G) + (size_t)1 * DM * DM;    t[6] = YS;          t[7] = WW(W_GLU);   t[8] = YS; t[9] = WW(W_GLU);
        t[10] = H; t[11] = WW(W_G) + (size_t)2 * DM * DM;   t[12] = WSB(OFF_O); t[13] = WW(W_MO);
        t[14] = H; t[15] = WW(W_G) + (size_t)3 * DM * DM;   t[16] = WSB(OFF_Z); t[17] = WW(W_HO);
    }
    pg8::gemm_phaseN(lds, MergeDesc{lds + LDS_TAB}, S, EpiFusedN{MG, gb, lds, {}});
}

DEVI void phase_mixout(const Params& p, int l, char* lds) {
    pg8::RowPanelOrder S; S.init(T_, DM, gdim(), bidx());
    if (l == 0) pg8::gemm_phase(lds, pg8::Gemm{WSB(OFF_MERGED), WW(W_MIX), T_, DM, DM}, S, pg8::EpiResid<true>{INF(I_X), XB, WSF(OFF_RSS), {}});
    else pg8::gemm_phase(lds, pg8::Gemm{WSB(OFF_MERGED), WW(W_MIX), T_, DM, DM}, S, pg8::EpiResid<false>{nullptr, XB, WSF(OFF_RSS), {}});
}
DEVI void phase_xo(const Params& p, int, char* lds) {
    pg8::RowPanelOrder S; S.init(T_, DM, gdim(), bidx());
    pg8::gemm_phase(lds, pg8::Gemm{WSB(OFF_OX), WW(W_XO), T_, DM, 512}, S, pg8::EpiResid<false>{nullptr, XB, WSF(OFF_RSS) + 4 * T_, {}});
}

DEVI void phase_xqkv(const Params& p, int, char* lds) {
    { pg8::StaticOrder S; S.init(T_, 512, gdim(), bidx());
      pg8::gemm_phase(lds, pg8::Gemm{XB, WW(W_XQ), T_, 512, DM, XLD}, S, pg8::EpiStoreScaled{WSB(OFF_QX), 512, WSF(OFF_RSS)}); }
    { pg8::StaticOrder S; S.init(NBATCH * 256, 1024, gdim(), bidx());
      pg8::gemm_phase(lds, pg8::Gemm{WSB(OFF_MEMN), WW(W_XKV), NBATCH * 256, 1024, DM}, S, pg8::EpiStoreBf16{WSB(OFF_KVX), 1024}); }
}

struct EpiRouter {
    static constexpr bool PERM = false;
    float* LG; const float* rss;
    DEVI void operator()(const f32x4 (&acc)[2][2][4][2], const pg8::Unit& u, int wr, int wc, int fr, int fq) const {
        if (wc >= 2) return;
        const int row0 = u.pm * 256 + wr * 64 + fr, col0 = wc * 32 + 4 * fq;
#pragma unroll
        for (int ai = 0; ai < 2; ++ai)
#pragma unroll
            for (int m = 0; m < 4; ++m) { const int row = row0 + ai * 128 + m * 16; const f32x4 pv = *(const f32x4*)(rss + (size_t)row * 4); const float r = rsqrtf((pv[0] + pv[1] + pv[2] + pv[3]) * (1.f / DM) + EPS);
#pragma unroll
                for (int n = 0; n < 2; ++n) *(f32x4*)(LG + (size_t)row * 64 + col0 + n * 16) = acc[ai][0][m][n] * r; }
    }
};
DEVI void phase_router_gemm(const Params& p, int, char* lds) {
    pg8::StaticOrder S; S.init(T_, 256, gdim(), bidx());
    pg8::gemm_phase(lds, pg8::Gemm{XB, WW(W_RT), T_, 256, DM, XLD}, S, EpiRouter{WSF(OFF_LOGIT), WSF(OFF_RSS) + 4 * T_});
}
DEVI void phase_route(const Params& p, int l, char* lds) {
    const int tid = tidx();
    unsigned* lc = (unsigned*)(lds + LDS_TAB);
    unsigned* gbs = lc + 64;
    unsigned* CNT = WSP(unsigned, OFF_CNT) + l * 64;
    const float* LG = WSF(OFF_LOGIT);
    const float* bg = INF(I_MOEBG) + l * 4; const float* be = INF(I_MOEBE) + l * 32;
    int* LIST = WSP(int, OFF_LIST); float* LW = WSF(OFF_LISTW);
    for (int base = bidx() * 256; base < T_; base += gdim() * 256) {
        const bool act = tid < 256; const int tok = base + (tid & 255);
        __syncthreads();
        if (tid < 64) lc[tid] = 0u;
        __syncthreads();
        const float* lg = LG + (size_t)tok * 64;
        float gl[4];
#pragma unroll
        for (int i = 0; i < 4; ++i) gl[i] = lg[i] + bg[i];
        int gi = 0; float gm = gl[0];
#pragma unroll
        for (int i = 1; i < 4; ++i) if (gl[i] > gm) { gm = gl[i]; gi = i; }
        float gs = 0.f;
#pragma unroll
        for (int i = 0; i < 4; ++i) gs += expf(gl[i] - gm);
        const float gw = 1.f / gs;
        float el[8];
#pragma unroll
        for (int i = 0; i < 8; ++i) el[i] = lg[4 + gi * 8 + i] + be[gi * 8 + i];
        int i1 = 0; float v1 = el[0];
#pragma unroll
        for (int i = 1; i < 8; ++i) if (el[i] > v1) { v1 = el[i]; i1 = i; }
        int i2 = -1; float v2 = -3.0e38f;
#pragma unroll
        for (int i = 0; i < 8; ++i) if (i != i1 && el[i] > v2) { v2 = el[i]; i2 = i; }
        const float w1 = 1.f / (1.f + expf(v2 - v1)), w2 = 1.f - w1;
        const int ke0 = gi * 8 + i1, ke1 = 32 + gi * 8 + i2;
        unsigned p0 = 0u, p1 = 0u; if (act) { p0 = atomicAdd(&lc[ke0], 1u); p1 = atomicAdd(&lc[ke1], 1u); }
        __syncthreads();
        if (tid < 64) gbs[tid] = lc[tid] ? atomicAdd(&CNT[tid], lc[tid]) : 0u;
        __syncthreads();
        const size_t s0 = (size_t)ke0 * 65536 + gbs[ke0] + p0, s1 = (size_t)ke1 * 65536 + gbs[ke1] + p1;
        if (act) { LIST[s0] = tok; LW[s0] = w1 * gw; LIST[s1] = tok; LW[s1] = w2 * gw; }
    }
}
DEVI void moe_tables(const Params& p, int l, char* lds) {
    unsigned* cnt = (unsigned*)(lds + LDS_TAB); unsigned* off = cnt + 64; unsigned* ts = off + 64;
    const unsigned* CNT = WSP(const unsigned, OFF_CNT) + l * 64;
    __syncthreads();
    if (tidx() < 64) cnt[tidx()] = CNT[tidx()];
    __syncthreads();
    if (tidx() == 0) { unsigned o = 0, t = 0; for (int i = 0; i < 64; ++i) { off[i] = o; ts[i] = t; o += cnt[i]; t += (cnt[i] + 255u) >> 8; } ts[64] = t; }
    __syncthreads();
}
struct MoeSched {
    const unsigned* ts;
    int kbeg, kend, nct, G, c;
    DEVI bool next(int i, pg8::Unit& u) const {
        const int L = i * G + c, tb = (int)ts[kbeg], te = (int)ts[kend];
        if (L >= (te - tb) * nct) return false;
        const int tile = tb + L / nct, ct = L % nct;
        int ke = kbeg;
#pragma nounroll
        for (int k = kbeg + 1; k < kend; ++k) if ((int)ts[k] <= tile) ke = k;
        u.pm = tile; u.pn = (ke & 31) * nct + ct; return true;
    }
    DEVI void a_ready(const pg8::Unit&) const {}
    DEVI void done(const pg8::Unit&) const {}
    const unsigned* cnt; const int* LIST;
    DEVI void unit_rows(const pg8::Unit& u, int& ke, int& slot_base, int& n) const {
        int lo = 0, hi = 64;
#pragma nounroll
        while (hi - lo > 1) { const int mid = (lo + hi) >> 1; if ((int)ts[mid] <= u.pm) lo = mid; else hi = mid; }
        ke = lo; slot_base = (u.pm - (int)ts[lo]) * 256; n = (int)cnt[lo];
    }
    DEVI unsigned row_off(int ke, int slot, int n) const {
        const int tok = slot < n ? LIST[(size_t)ke * 65536 + slot] : 0;
        return (unsigned)tok * (unsigned)(XLD * 2);
    }
};
DEVI void phase_moe_gather(const Params& p, int l, char* lds) {
    moe_tables(p, l, lds);
    const unsigned* cnt = (const unsigned*)(lds + LDS_TAB); const unsigned* ts = cnt + 128;
    const int* LIST = WSP(const int, OFF_LIST); const float* LW = WSF(OFF_LISTW);
    float* WG = WSF(OFF_WGT); int* RI = WSP(int, OFF_ROWIDX); float* RSG = WSF(OFF_RSG); const float* rss = WSF(OFF_RSS) + 4 * T_;
    const int nrows = (int)ts[64] * 256;
    for (int r = bidx() * NTHR + tidx(); r < nrows; r += gdim() * NTHR) {
        const int tile = r >> 8;
        int lo = 0, hi = 64;
#pragma nounroll
        while (hi - lo > 1) { const int mid = (lo + hi) >> 1; if ((int)ts[mid] <= tile) lo = mid; else hi = mid; }
        const int slot = r - (int)ts[lo] * 256;
        if (slot < (int)cnt[lo]) { const int tok = LIST[(size_t)lo * 65536 + slot]; WG[r] = LW[(size_t)lo * 65536 + slot]; RI[(size_t)(lo >> 5) * T_ + tok] = r;
            const f32x4 pv = *(const f32x4*)(rss + (size_t)tok * 4); RSG[r] = rsqrtf((pv[0] + pv[1] + pv[2] + pv[3]) * (1.f / DM) + EPS); }
        else { WG[r] = 0.f; RSG[r] = 0.f; }
    }
}
struct EpiMoeGU {
    static constexpr bool PERM = false;
    bf16_t* HB; const float* WG; const float* RSG;
    DEVI void operator()(const f32x4 (&acc)[2][2][4][2], const pg8::Unit& u, int wr, int wc, int fr, int fq) const {
        const int row0 = u.pm * 256 + wr * 64 + fr, ct = u.pn & 1;
        float wv[8], rv[8];
#pragma unroll
        for (int i = 0; i < 8; ++i) { const int row = row0 + (i >> 2) * 128 + (i & 3) * 16; wv[i] = WG[row]; rv[i] = RSG[row]; }
#pragma unroll
        for (int ai = 0; ai < 2; ++ai)
#pragma unroll
            for (int m = 0; m < 4; ++m) {
                const int row = row0 + ai * 128 + m * 16;
                const float rs = rv[ai * 4 + m], wrs = wv[ai * 4 + m] * rs;
#pragma unroll
                for (int bj = 0; bj < 2; ++bj) {
                    const int hc = ct * 128 + bj * 64 + wc * 16 + 4 * fq;
                    f32x4 o;
#pragma unroll
                    for (int q = 0; q < 4; ++q) { const float g = acc[ai][bj][m][0][q] * rs; o[q] = g * sigmoid_(g) * acc[ai][bj][m][1][q] * wrs; }
                    *(u32x2*)(HB + (size_t)row * 256 + hc) = pack4(o);
                }
            }
    }
};
DEVI void phase_moe_gu(const Params& p, int l, char* lds) {
    moe_tables(p, l, lds);
    const unsigned* cnt = (const unsigned*)(lds + LDS_TAB); const unsigned* ts = cnt + 128;
    MoeSched S{ts, 0, 64, 2, gdim(), bidx(), cnt, WSP(const int, OFF_LIST)};
    pg8::gemm_phase_gather(lds, pg8::Gemm{XB, WW(W_GU), 0, 0, DM}, S,
                           EpiMoeGU{WSB(OFF_HBUF), WSF(OFF_WGT), WSF(OFF_RSG)});
}
struct EpiMoeDown {
    static constexpr bool PERM = true;
    bf16_t* YD;
    DEVI void operator()(const f32x4 (&acc)[2][2][4][2], const pg8::Unit& u, int wr, int wc, int fr, int fq) const {
        bf16_t* base = YD + (size_t)(u.pm * 256 + wr * 64 + fr) * DM + (u.pn & 3) * 256 + wc * 32 + 8 * fq;
#pragma unroll
        for (int ai = 0; ai < 2; ++ai)
#pragma unroll
            for (int m = 0; m < 4; ++m)
#pragma unroll
                for (int bj = 0; bj < 2; ++bj) {
                    const u32x4 w = {pk2(acc[ai][bj][m][0][0], acc[ai][bj][m][0][1]), pk2(acc[ai][bj][m][0][2], acc[ai][bj][m][0][3]),
                                     pk2(acc[ai][bj][m][1][0], acc[ai][bj][m][1][1]), pk2(acc[ai][bj][m][1][2], acc[ai][bj][m][1][3])};
                    *(u32x4*)(base + (size_t)(ai * 128 + m * 16) * DM + bj * 128) = w; }
    }
};
DEVI void phase_moe_down(const Params& p, int l, char* lds) {
    moe_tables(p, l, lds);
    const unsigned* ts = (const unsigned*)(lds + LDS_TAB) + 128;
    MoeSched S{ts, 0, 64, 4, gdim(), bidx(), nullptr, nullptr};
    pg8::gemm_phase(lds, pg8::Gemm{WSB(OFF_HBUF), WW(W_D), 0, 0, 256}, S, EpiMoeDown{WSB(OFF_YD)});
}
DEVI void phase_final(const Params& p, int, char*) { moe_combine_norm<true>(p, INF(I_FINALNORM), nullptr); }

#define PHASE_LIST(X) \
    X(prologue) X(weights) X(norm_mix) X(pgemm) X(mixA) X(mla_prep) X(qkv) X(mla_attn) X(s5) X(hy_pre) X(hy_conv<0>) X(hy_conv<1>) \
    X(hy_post) X(merge) X(mixout) X(norm_xa) X(xqkv) X(x_attn) X(xo) X(norm_moe) X(router_gemm) X(route) X(moe_gather) X(moe_gu) X(moe_down) X(final)

#if !MEGA
template <int PH>
__global__ void __launch_bounds__(NTHR, 2) k_phase(Params p, int l) {
    extern __shared__ __attribute__((aligned(16))) char lds[];
    if constexpr (PH == 0) phase_prologue(p, l, lds);
    else if constexpr (PH == 1) phase_weights(p, l, lds);
    else if constexpr (PH == 2) phase_norm_mix(p, l, lds);
    else if constexpr (PH == 3) phase_pgemm(p, l, lds);
    else if constexpr (PH == 4) phase_mixA(p, l, lds);
    else if constexpr (PH == 5) phase_mla_prep(p, l, lds);
    else if constexpr (PH == 6) phase_qkv(p, l, lds);
    else if constexpr (PH == 7) phase_mla_attn(p, l, lds);
    else if constexpr (PH == 8) phase_s5(p, l, lds);
    else if constexpr (PH == 9) { }
    else if constexpr (PH == 10) phase_hy_conv<0>(p, l, lds);
    else if constexpr (PH == 11) phase_hy_conv<1>(p, l, lds);
    else if constexpr (PH == 12) phase_hy_post(p, l, lds);
    else if constexpr (PH == 13) phase_merge(p, l, lds);
    else if constexpr (PH == 14) phase_mixout(p, l, lds);
    else if constexpr (PH == 15) phase_norm_xa(p, l, lds);
    else if constexpr (PH == 16) phase_xqkv(p, l, lds);
    else if constexpr (PH == 17) phase_x_attn(p, l, lds);
    else if constexpr (PH == 18) phase_xo(p, l, lds);
    else if constexpr (PH == 19) phase_norm_moe(p, l, lds);
    else if constexpr (PH == 20) phase_router_gemm(p, l, lds);
    else if constexpr (PH == 21) phase_route(p, l, lds);
    else if constexpr (PH == 22) phase_moe_gu(p, l, lds);
    else if constexpr (PH == 23) phase_moe_down(p, l, lds);
    else if constexpr (PH == 25) phase_final(p, l, lds);
    else if constexpr (PH == 26) phase_moe_gather(p, l, lds);
}
template <int PH> static void launch_phase(const Params& p, int l, int grid, hipStream_t s) {
    static bool attr = false;
    if (!attr) { hipFuncSetAttribute((const void*)k_phase<PH>, hipFuncAttributeMaxDynamicSharedMemorySize, LDS_TOTAL); attr = true; }
    hipLaunchKernelGGL(k_phase<PH>, dim3(grid), dim3(NTHR), LDS_TOTAL, s, p, l);
}
#else
__global__ void __launch_bounds__(NTHR, 2) k_mega(Params p) {
    extern __shared__ __attribute__((aligned(16))) char lds[];
    uint4* xbw = (uint4*)(lds + LDS_TAB + 2048);
    if (threadIdx.x == 0) *xbw = make_uint4(0u, 0u, 0u, 0u);
    if ((threadIdx.x & 63) == 0) *(int*)(lds + LDS_WID + ((unsigned)__builtin_amdgcn_s_getreg((5 << 11) | 4) & 63u) * 4) = (int)(threadIdx.x >> 6);
    __syncthreads();
    XcdBarrier bar = xcd_barrier_post((unsigned*)(p.ws + OFF_BAR), (volatile LAS unsigned*)xbw);
#if defined(__HIP_DEVICE_COMPILE__)
#define LOAD_Q() Params q; { typedef const __attribute__((address_space(4))) Params* KParamPtr; KParamPtr kp = (KParamPtr)__builtin_amdgcn_kernarg_segment_ptr(); \
    asm volatile("" : "+s"(kp)); _Pragma("unroll") for (int i_ = 0; i_ < N_INPUTS; ++i_) q.in[i_] = kp->in[i_]; q.out = kp->out; q.ws = kp->ws; }
#else
#define LOAD_Q() Params q = p;
#endif
#define PH_(name) { LOAD_Q(); phase_##name(q, l, lds); } xcd_barrier(bar);
    { const int l = 0; LOAD_Q(); phase_prologue(q, l, lds); }
#pragma nounroll
    for (int l = 0; l < 2; ++l) {
        { LOAD_Q(); phase_weights(q, l, lds); } PH_(norm_mix) PH_(pgemm) { LOAD_Q(); phase_mixA(q, l, lds); } PH_(mla_prep) PH_(qkv) PH_(mla_attn) PH_(s5)
        PH_(hy_conv01) PH_(hy_post) PH_(merge) PH_(mixout) PH_(xqkv) PH_(x_attn) PH_(xo)
        PH_(router_gemm) PH_(route) PH_(moe_gather) PH_(moe_gu) PH_(moe_down)
    }
    { LOAD_Q(); phase_final(q, 0, lds); }
}
#endif


#ifndef DEBUG_NAN
#define DEBUG_NAN 0
#endif
#if DEBUG_NAN
__global__ void k_check(const void* ptr, size_t n, int isf32, unsigned* flags, int idx) {
    size_t i = (size_t)blockIdx.x * blockDim.x + threadIdx.x; const size_t stride = (size_t)gridDim.x * blockDim.x;
    bool bad = false;
    if (isf32) { const unsigned* q = (const unsigned*)ptr; for (; i < n; i += stride) bad |= ((q[i] & 0x7f800000u) >= 0x49800000u); }
    else { const unsigned short* q = (const unsigned short*)ptr; for (; i < n; i += stride) bad |= ((q[i] & 0x7f80u) >= 0x4980u); }
    if (bad) flags[idx] = 1u;
}
__global__ void k_report(float* out, size_t n, const unsigned* flags, int nflags) {
    int f = 0; for (int i = 1; i <= nflags; ++i) if (flags[i]) { f = i; break; }
    for (size_t i = (size_t)blockIdx.x * blockDim.x + threadIdx.x; i < n; i += (size_t)gridDim.x * blockDim.x) out[i] = (float)f;
}
#endif

#if DEBUG_NAN
__global__ void k_count(const void* ptr, size_t n, unsigned long long* cnt) {
    size_t i = (size_t)blockIdx.x * blockDim.x + threadIdx.x; const size_t stride = (size_t)gridDim.x * blockDim.x;
    unsigned long long c = 0; const unsigned short* q = (const unsigned short*)ptr;
    for (; i < n; i += stride) c += ((q[i] & 0x7f80u) >= 0x4980u) ? 1ull : 0ull;
    if (c) atomicAdd(cnt, c);
}
__global__ void k_report2(float* out, size_t n, const unsigned long long* cnt) {
    const unsigned long long c = *cnt; int f = 0; while ((1ull << f) <= c) ++f;
    for (size_t i = (size_t)blockIdx.x * blockDim.x + threadIdx.x; i < n; i += (size_t)gridDim.x * blockDim.x) out[i] = (float)f;
}
#endif

#if DEBUG_NAN
#ifndef DBG_MODE
#define DBG_MODE 1
#endif
__global__ void k_diag(const unsigned short* q, unsigned* masks) {
    size_t i = (size_t)blockIdx.x * blockDim.x + threadIdx.x; const size_t stride = (size_t)gridDim.x * blockDim.x;
    unsigned im = 0, am = 0, bm = 0;
    for (; i < (size_t)T_ * 512; i += stride) {
        if ((q[i] & 0x7f80u) >= 0x4980u) {
            const int row = (int)(i >> 9), col = (int)(i & 511);
            const int pm = row >> 8, pn = col >> 7, u = pm * 4 + pn;
            im |= 1u << (u >> 8);
            am |= 1u << ((((row & 255) >> 6) << 1) | ((col & 127) >> 6));
            bm |= 1u << (u & 7);
        }
    }
    if (im) atomicOr(&masks[0], im);
    if (am) atomicOr(&masks[1], am);
    if (bm) atomicOr(&masks[2], bm);
}
__global__ void k_report3(float* out, size_t n, const unsigned* masks) {
    float f;
    if (DBG_MODE == 0) f = (float)masks[0];
    else if (DBG_MODE == 1) f = (float)__popc(masks[1]) + 10.f * (float)(masks[1] & 1u) + 20.f * (float)((masks[1] >> 7) & 1u);
    else f = (float)__popc(masks[2]);
    for (size_t i = (size_t)blockIdx.x * blockDim.x + threadIdx.x; i < n; i += (size_t)gridDim.x * blockDim.x) out[i] = f;
}
#endif

#if DEBUG_NAN
__global__ void k_wcheck(const unsigned short* w, unsigned* flags, int base) {
    const size_t offs[16] = {W_P, W_G, W_OA, W_GLU, W_QB, W_KVB, W_MO, W_HO, W_MIX, W_XQ, W_XKV, W_XO, W_RT, W_GU, W_D, 40042496};
    for (int m = 0; m < 15; ++m) {
        bool bad = false;
        for (size_t i = offs[m] + (size_t)blockIdx.x * blockDim.x + threadIdx.x; i < offs[m + 1]; i += (size_t)gridDim.x * blockDim.x) bad |= ((w[i] & 0x7f80u) >= 0x4180u);
        if (bad) flags[base + m + 1] = 1u;
    }
}
#endif

#if DEBUG_NAN
__global__ void k_vgemm(const unsigned short* A, int lda, const unsigned short* Bt, int ldb, int K, const unsigned short* C, int ldc, int M, int N, int rstride,
                        unsigned long long* cnt) {
    const int nrows = (M + rstride - 1) / rstride;
    unsigned long long bad = 0;
    for (size_t idx = (size_t)blockIdx.x * blockDim.x + threadIdx.x; idx < (size_t)nrows * N; idx += (size_t)gridDim.x * blockDim.x) {
        const int r = (int)(idx / N) * rstride, c = (int)(idx % N);
        const unsigned short* a = A + (size_t)r * lda; const unsigned short* b = Bt + (size_t)c * ldb;
        float acc = 0.f;
        for (int k = 0; k < K; ++k) acc += __uint_as_float((unsigned)a[k] << 16) * __uint_as_float((unsigned)b[k] << 16);
        const float v = __uint_as_float((unsigned)C[(size_t)r * ldc + c] << 16);
        if (!(fabsf(v - acc) <= 0.05f + 0.02f * fabsf(acc))) ++bad;
    }
    if (bad) atomicAdd(cnt, bad);
}
__global__ void k_report4(float* out, size_t n, const unsigned long long* cnt) {
    int f = 0; { const unsigned long long c = cnt[0]; while ((1ull << f) <= c) ++f; }
    if (f == 0) { int g = 0; const unsigned long long c = cnt[1]; while ((1ull << g) <= c) ++g; if (g) f = 30 + g; }
    for (size_t i = (size_t)blockIdx.x * blockDim.x + threadIdx.x; i < n; i += (size_t)gridDim.x * blockDim.x) out[i] = (float)f;
}
#endif

extern "C" void kernel_launch(void* const* d_in, const int* in_sizes, int n_in, void* d_out, int out_size, void* d_ws, size_t ws_size,
                              hipStream_t stream) {
    if (n_in != N_INPUTS || ws_size < WS_NEED || out_size != T_ * DM) {
        fprintf(stderr, "kernel_launch: unexpected shapes: n_in %d ws %zu out %d\n", n_in, ws_size, out_size);
        return;
    }
    Params p{};
    for (int i = 0; i < N_INPUTS; ++i) p.in[i] = d_in[i];
    p.out = (float*)d_out; p.ws = (char*)d_ws;
    static int grid = 0;
    if (!grid) { int dev = 0, cus = 0; hipGetDevice(&dev); hipDeviceGetAttribute(&cus, hipDeviceAttributeMultiprocessorCount, dev); grid = cus > 0 ? cus : 256; }
#if !MEGA
#if DEBUG_NAN
    unsigned* flags = (unsigned*)(p.ws + OFF_CNT + 4096);
    hipMemsetAsync(flags, 0, 1024, stream);
    int cidx = 0;
    auto chk = [&](size_t off, size_t n, int isf32) { hipLaunchKernelGGL(k_check, dim3(1024), dim3(256), 0, stream, (const void*)(p.ws + off), n, isf32, flags, cidx); };
    auto chko = [&]() { hipLaunchKernelGGL(k_check, dim3(1024), dim3(256), 0, stream, (const void*)p.out, (size_t)T_ * DM, 1, flags, cidx); };
#define CHK(...) do { ++cidx; __VA_ARGS__; } while (0)
#else
#define CHK(...) do { } while (0)
#endif
    const size_t TT = T_;
    launch_phase<0>(p, 0, grid, stream);
    CHK(chk(OFF_ROPE_C, TT * 32, 1); chk(OFF_MEMN, 4096 * 1024, 0));
    for (int l = 0; l < 2; ++l) {
        launch_phase<1>(p, l, grid, stream);  CHK(chk(OFF_W, 40042496, 0); chk(OFF_H2, 4096 * 64, 1));
        launch_phase<2>(p, l, grid, stream);  CHK(chk(OFF_H, TT * 1024, 0));
        launch_phase<3>(p, l, grid, stream);

        CHK(chk(OFF_PA, TT * 1536, 0); chk(OFF_PS, TT * 512, 0); chk(OFF_PM, TT * 640, 0); chk(OFF_PH, TT * 1536, 0); chk(OFF_RTAB, 2 * 512 * 8192, 0));
        launch_phase<4>(p, l, grid, stream);  CHK(chk(OFF_ZA, TT * 512, 0));
        launch_phase<5>(p, l, grid, stream);  CHK(chk(OFF_CQN, TT * 544, 0));
        launch_phase<6>(p, l, grid, stream);  CHK(chk(OFF_Q, TT * 768, 0)); CHK(chk(OFF_KV, TT * 1024, 0));
        launch_phase<7>(p, l, grid, stream);  CHK(chk(OFF_O, TT * 512, 0));
        launch_phase<8>(p, l, grid, stream);  CHK(chk(OFF_YSF, TT * 1024, 0));
        launch_phase<9>(p, l, grid, stream);  CHK(chk(OFF_VT, TT * 1536, 0));
        launch_phase<10>(p, l, grid, stream); CHK(chk(OFF_Z1T, TT * 512, 0));
        launch_phase<11>(p, l, grid, stream); CHK(chk(OFF_ZT, TT * 512, 0));
        launch_phase<12>(p, l, grid, stream); CHK(chk(OFF_Z, TT * 512, 0));
        launch_phase<13>(p, l, grid, stream); CHK(chk(OFF_MERGED, TT * 1024, 0));
        launch_phase<14>(p, l, grid, stream); CHK(chko());
        launch_phase<15>(p, l, grid, stream); CHK(chk(OFF_H, TT * 1024, 0));
        launch_phase<16>(p, l, grid, stream);
 CHK(chk(OFF_QX, TT * 512, 0)); CHK(chk(OFF_KVX, 4096 * 1024, 0));

        launch_phase<17>(p, l, grid, stream); CHK(chk(OFF_OX, TT * 512, 0));
        launch_phase<18>(p, l, grid, stream); CHK(chko());
        launch_phase<19>(p, l, grid, stream); CHK(chk(OFF_H, TT * 1024, 0));
        launch_phase<20>(p, l, grid, stream); CHK(chk(OFF_LOGIT, TT * 64, 1));
        launch_phase<21>(p, l, grid, stream); launch_phase<26>(p, l, grid, stream);
        launch_phase<22>(p, l, grid, stream); CHK(chk(OFF_HBUF, TT * 512, 0));
        launch_phase<23>(p, l, grid, stream);
    }
    launch_phase<25>(p, 0, grid, stream);
#if DEBUG_NAN
    hipLaunchKernelGGL(k_report, dim3(1024), dim3(256), 0, stream, p.out, (size_t)T_ * DM, (const unsigned*)flags, cidx);
#endif
#else
    static bool attr = false;
    if (!attr) {
        hipFuncSetAttribute((const void*)k_mega, hipFuncAttributeMaxDynamicSharedMemorySize, LDS_TOTAL); attr = true;
        int dev = 0, cus = 0, per_cu = 0; hipGetDevice(&dev); hipDeviceGetAttribute(&cus, hipDeviceAttributeMultiprocessorCount, dev);
        if (hipOccupancyMaxActiveBlocksPerMultiprocessor(&per_cu, (const void*)k_mega, NTHR, LDS_TOTAL) == hipSuccess && per_cu >= 1 && cus > 0) grid = cus;
    }
    hipMemsetAsync(p.ws + OFF_BAR, 0, XCD_BAR_WORDS * sizeof(unsigned), stream);
    hipLaunchKernelGGL(k_mega, dim3(grid), dim3(NTHR), LDS_TOTAL, stream, p);
#endif
}
```
